# Optimizing an MI355X kernel written in HIP

```python
import math
import jax
import jax.numpy as jnp
from jax import lax
import numpy as np

D_MODEL = 1024
BATCH = 8
SEQ = 4096
DEPTH = 1

CHUNK = 64
MIX_WIDTH = D_MODEL
DN_WIDTH = MIX_WIDTH // 2
DN_HEAD_DIM = 128
DN_HEADS = DN_WIDTH // DN_HEAD_DIM
CONV_WIDTH = 4
CA_WIDTH = MIX_WIDTH - DN_WIDTH
CA_HEAD_DIM = 64
CA_HEADS = CA_WIDTH // CA_HEAD_DIM
CA_LEFT_CHUNKS = 8
MAX_REL_DIST = 256
N_EXPERTS = 32
TOP_K = 4
D_EXPERT = D_MODEL
SWIGLU_LIMIT = 7.0
SWIGLU_ALPHA = 1.702
EXPERT_BLOCK = 128
NORM_EPS = 1e-6
IN_SPLITS = (DN_WIDTH, DN_WIDTH, DN_WIDTH, DN_WIDTH, DN_HEADS, DN_HEADS, CA_WIDTH, CA_WIDTH, CA_WIDTH)
IN_WIDTH = sum(IN_SPLITS)

kernel_name = 'hybrid_deltanet_chunkattn_moe_block'


def rmsnorm(x, w):
    xf = x.astype(jnp.float32)
    y = xf * lax.rsqrt(jnp.mean(xf * xf, axis=-1, keepdims=True) + NORM_EPS)
    return (y * w.astype(jnp.float32)).astype(x.dtype)


def l2norm(x):
    return x * lax.rsqrt(jnp.sum(x * x, axis=-1, keepdims=True) + NORM_EPS)


def causal_depthwise_conv(x, w):
    k, c = w.shape
    return lax.conv_general_dilated(
        x, w[:, None, :].astype(x.dtype), window_strides=(1,), padding=[(k - 1, 0)],
        dimension_numbers=('NWC', 'WIO', 'NWC'), feature_group_count=c)


def gated_deltanet(q, k, v, z, b, a, a_log, dt_bias, norm_w):
    f32 = jnp.float32
    bsz, seq, _ = q.shape
    n_chunks = seq // CHUNK
    H, dh = DN_HEADS, DN_HEAD_DIM

    def heads(t):
        return t.astype(f32).reshape(bsz, seq, H, dh)

    def chunks(t):
        return t.reshape(bsz, n_chunks, CHUNK, H, -1).transpose(0, 3, 1, 2, 4)

    qh = chunks(l2norm(heads(q)) * (dh ** -0.5))
    kh = chunks(l2norm(heads(k)))
    vh = chunks(heads(v))
    beta = jax.nn.sigmoid(b.astype(f32))
    g = -jnp.exp(a_log.astype(f32)) * jax.nn.softplus(a.astype(f32) + dt_bias.astype(f32))
    beta = chunks(beta[..., None])[..., 0]
    gc = jnp.cumsum(chunks(g[..., None])[..., 0], axis=-1)
    causal = jnp.tril(jnp.ones((CHUNK, CHUNK), dtype=bool))
    strict = jnp.tril(jnp.ones((CHUNK, CHUNK), dtype=bool), k=-1)
    decay = jnp.exp(jnp.where(causal, gc[..., :, None] - gc[..., None, :], -jnp.inf))
    k_beta = kh * beta[..., None]
    lower = jnp.where(strict, jnp.einsum('bhnid,bhnjd->bhnij', k_beta, kh) * decay, 0.0)
    eye = jnp.eye(CHUNK, dtype=f32)
    rhs = jnp.concatenate([vh * beta[..., None], k_beta * jnp.exp(gc)[..., None]], axis=-1)
    sol = lax.linalg.triangular_solve(lower + eye, rhs, left_side=True, lower=True, unit_diagonal=True)
    u, w = sol[..., :dh], sol[..., dh:]
    qk = jnp.einsum('bhnid,bhnjd->bhnij', qh, kh) * decay
    q_dec = qh * jnp.exp(gc)[..., None]
    k_dec = kh * jnp.exp(gc[..., -1:] - gc)[..., None]
    chunk_decay = jnp.exp(gc[..., -1])

    def step(state, inp):
        u_n, w_n, qd_n, kd_n, qk_n, cd_n = inp
        v_new = u_n - jnp.einsum('bhck,bhkv->bhcv', w_n, state)
        o_n = jnp.einsum('bhck,bhkv->bhcv', qd_n, state) + jnp.einsum('bhij,bhjv->bhiv', qk_n, v_new)
        state = state * cd_n[..., None, None] + jnp.einsum('bhck,bhcv->bhkv', kd_n, v_new)
        return state, o_n

    xs = (jnp.moveaxis(u, 2, 0), jnp.moveaxis(w, 2, 0), jnp.moveaxis(q_dec, 2, 0),
          jnp.moveaxis(k_dec, 2, 0), jnp.moveaxis(qk, 2, 0), jnp.moveaxis(chunk_decay, 2, 0))
    state0 = jnp.zeros((bsz, H, dh, dh), f32)
    _, o = lax.scan(step, state0, xs)
    o = o.transpose(1, 0, 3, 2, 4).reshape(bsz, seq, H, dh)
    o = o * lax.rsqrt(jnp.mean(o * o, axis=-1, keepdims=True) + NORM_EPS) * norm_w.astype(f32)
    o = o * jax.nn.silu(heads(z))
    return o.reshape(bsz, seq, DN_WIDTH).astype(q.dtype)


def chunk_band_attention(q, k, v, rel_bias, norm_w):
    f32 = jnp.float32
    bsz, seq, _ = q.shape
    H, d = CA_HEADS, CA_HEAD_DIM
    n_chunks = seq // CHUNK
    band_chunks = CA_LEFT_CHUNKS + 1
    qc = q.reshape(bsz, n_chunks, CHUNK, H, d)

    def band(t):
        tc = t.reshape(bsz, n_chunks, CHUNK, H, d)
        tp = jnp.pad(tc, ((0, 0), (CA_LEFT_CHUNKS, 0), (0, 0), (0, 0), (0, 0)))
        return jnp.concatenate([tp[:, o:o + n_chunks] for o in range(band_chunks)], axis=2)

    kb, vb = band(k), band(v)
    s = jnp.einsum('bnihd,bnjhd->bhnij', qc, kb).astype(f32) * (d ** -0.5)
    qi = jnp.arange(CHUNK)
    kj = jnp.arange(band_chunks * CHUNK)
    dist = qi[:, None] + CA_LEFT_CHUNKS * CHUNK - kj[None, :]
    bias_idx = jnp.clip(dist, -MAX_REL_DIST, MAX_REL_DIST) + MAX_REL_DIST
    bias = rel_bias.astype(f32)[:, bias_idx]
    valid = (jnp.arange(n_chunks)[:, None] - CA_LEFT_CHUNKS + kj[None, :] // CHUNK) >= 0
    s = jnp.where(valid[None, None, :, None, :], s + bias[None, :, None], -jnp.inf)
    p = jax.nn.softmax(s, axis=-1).astype(v.dtype)
    o = jnp.einsum('bhnij,bnjhd->bnihd', p, vb).reshape(bsz, seq, H * d)
    return rmsnorm(o, norm_w)


def moe(h, w_router, b_router, w_gate, b_gate, w_up, b_up, w_down, b_down):
    bsz, seq, dm = h.shape
    n_tok = bsz * seq
    xf = h.reshape(n_tok, dm)
    logits = (xf @ w_router).astype(jnp.float32) + b_router.astype(jnp.float32)
    top_v, top_i = lax.top_k(logits, TOP_K)
    gates = jax.nn.softmax(top_v, axis=-1)
    n_assign = n_tok * TOP_K
    flat_e = top_i.reshape(-1)
    flat_tok = jnp.repeat(jnp.arange(n_tok, dtype=jnp.int32), TOP_K)
    flat_gate = gates.reshape(-1)
    order = jnp.argsort(flat_e, stable=True)
    sorted_e = flat_e[order]
    counts = jnp.bincount(flat_e, length=N_EXPERTS)
    padded = (counts + EXPERT_BLOCK - 1) // EXPERT_BLOCK * EXPERT_BLOCK
    start = jnp.cumsum(counts) - counts
    pad_end = jnp.cumsum(padded)
    pad_start = pad_end - padded
    dest = pad_start[sorted_e] + (jnp.arange(n_assign) - start[sorted_e])
    n_blocks = -(-n_assign // EXPERT_BLOCK) + N_EXPERTS
    n_slots = n_blocks * EXPERT_BLOCK
    slot_tok = jnp.zeros((n_slots,), jnp.int32).at[dest].set(flat_tok[order])
    slot_gate = jnp.zeros((n_slots,), jnp.float32).at[dest].set(flat_gate[order])
    block_e = jnp.minimum(
        jnp.searchsorted(pad_end, jnp.arange(n_blocks) * EXPERT_BLOCK, side='right'), N_EXPERTS - 1)
    xs = xf[slot_tok].reshape(n_blocks, EXPERT_BLOCK, dm)

    def expert_fn(args):
        xb, e = args
        gate = xb @ w_gate[e] + b_gate[e]
        up = xb @ w_up[e] + b_up[e]
        gate = jnp.minimum(gate, SWIGLU_LIMIT)
        up = jnp.clip(up, -SWIGLU_LIMIT, SWIGLU_LIMIT)
        glu = gate * jax.nn.sigmoid(gate * SWIGLU_ALPHA)
        return ((up + 1.0) * glu) @ w_down[e] + b_down[e]

    ys = lax.map(expert_fn, (xs, block_e)).reshape(n_slots, dm).astype(jnp.float32)
    out = jnp.zeros((n_tok, dm), jnp.float32).at[slot_tok].add(ys * slot_gate[:, None])
    return out.reshape(bsz, seq, dm).astype(h.dtype)


def hybrid_layer(x, norm1_w, w_in, conv_w, a_log, dt_bias, dn_norm_w, rel_bias, attn_norm_w,
                 w_out, norm2_w, w_router, b_router, w_gate, b_gate, w_up, b_up, w_down, b_down):
    h = rmsnorm(x, norm1_w)
    proj = h @ w_in
    split_at = np.cumsum(IN_SPLITS)[:-1].tolist()
    q_a, k_a, v_a, z_a, b_a, a_a, q_b, k_b, v_b = jnp.split(proj, split_at, axis=-1)
    qkv_a = jax.nn.silu(causal_depthwise_conv(jnp.concatenate([q_a, k_a, v_a], axis=-1), conv_w))
    q_a, k_a, v_a = jnp.split(qkv_a, 3, axis=-1)
    o_a = gated_deltanet(q_a, k_a, v_a, z_a, b_a, a_a, a_log, dt_bias, dn_norm_w)
    o_b = chunk_band_attention(q_b, k_b, v_b, rel_bias, attn_norm_w)
    x = x + jnp.concatenate([o_a, o_b], axis=-1) @ w_out
    x = x + moe(rmsnorm(x, norm2_w), w_router, b_router, w_gate, b_gate, w_up, b_up, w_down, b_down)
    return x


def setup_inputs(seed: int = 0) -> dict:
    key = jax.random.key(seed)
    ks = jax.random.split(key, 20)
    L, D, E, F = DEPTH, D_MODEL, N_EXPERTS, D_EXPERT

    def nrm(k, shape, scale):
        return jax.random.normal(k, shape, jnp.float32) * scale

    def gain(k, shape):
        return 1.0 + 0.02 * jax.random.normal(k, shape, jnp.float32)

    x = nrm(ks[0], (BATCH, SEQ, D), 1.0)
    norm1_w = gain(ks[1], (L, D))
    w_in = nrm(ks[2], (L, D, IN_WIDTH), D ** -0.5)
    conv_w = nrm(ks[3], (L, CONV_WIDTH, 3 * DN_WIDTH), CONV_WIDTH ** -0.5)
    a_log = jnp.log(jax.random.uniform(ks[4], (L, DN_HEADS), jnp.float32, 1.0, 16.0))
    dt = jnp.exp(jax.random.uniform(ks[5], (L, DN_HEADS), jnp.float32, math.log(1e-3), math.log(1e-1)))
    dt_bias = dt + jnp.log(-jnp.expm1(-dt))
    dn_norm_w = gain(ks[6], (L, DN_HEAD_DIM))
    rel_bias = nrm(ks[7], (L, CA_HEADS, 2 * MAX_REL_DIST + 1), 0.5)
    attn_norm_w = gain(ks[8], (L, CA_WIDTH))
    w_out = nrm(ks[9], (L, MIX_WIDTH, D), MIX_WIDTH ** -0.5)
    norm2_w = gain(ks[10], (L, D))
    w_router = nrm(ks[11], (L, D, E), D ** -0.5)
    b_router = nrm(ks[12], (L, E), 0.01)
    w_gate = nrm(ks[13], (L, E, D, F), D ** -0.5)
    b_gate = nrm(ks[14], (L, E, F), 0.01)
    w_up = nrm(ks[15], (L, E, D, F), D ** -0.5)
    b_up = nrm(ks[16], (L, E, F), 0.01)
    w_down = nrm(ks[17], (L, E, F, D), F ** -0.5)
    b_down = nrm(ks[18], (L, E, D), 0.01)
    final_norm_w = gain(ks[19], (D,))
    return {'x': x, 'norm1_w': norm1_w, 'w_in': w_in, 'conv_w': conv_w, 'a_log': a_log,
            'dt_bias': dt_bias, 'dn_norm_w': dn_norm_w, 'rel_bias': rel_bias,
            'attn_norm_w': attn_norm_w, 'w_out': w_out, 'norm2_w': norm2_w,
            'w_router': w_router, 'b_router': b_router, 'w_gate': w_gate, 'b_gate': b_gate,
            'w_up': w_up, 'b_up': b_up, 'w_down': w_down, 'b_down': b_down,
            'final_norm_w': final_norm_w}


def reference(x, norm1_w, w_in, conv_w, a_log, dt_bias, dn_norm_w, rel_bias, attn_norm_w,
              w_out, norm2_w, w_router, b_router, w_gate, b_gate, w_up, b_up, w_down, b_down,
              final_norm_w):
    for l in range(DEPTH):
        x = hybrid_layer(x, norm1_w[l], w_in[l], conv_w[l], a_log[l], dt_bias[l], dn_norm_w[l],
                         rel_bias[l], attn_norm_w[l], w_out[l], norm2_w[l], w_router[l],
                         b_router[l], w_gate[l], b_gate[l], w_up[l], b_up[l], w_down[l], b_down[l])
    return rmsnorm(x, final_norm_w)
```

```cpp
#include <hip/hip_runtime.h>
#include <cstdio>
#include <cstdint>

#define LAS __attribute__((address_space(3)))
#define GAS __attribute__((address_space(1)))
typedef unsigned short bf16_t;
typedef short bf16x8 __attribute__((ext_vector_type(8)));
typedef float f32x4 __attribute__((ext_vector_type(4)));
typedef float f32x2 __attribute__((ext_vector_type(2)));
typedef unsigned u32x4 __attribute__((ext_vector_type(4)));
typedef unsigned u32x2 __attribute__((ext_vector_type(2)));
typedef GAS unsigned gu32;

constexpr int D = 1024, BATCH = 8, SEQ = 4096, M = BATCH * SEQ;
constexpr int CH = 64, NCH = SEQ / CH;
constexpr int DNH = 4, DNHD = 128;
constexpr int CAH = 8, CAD = 64, CALEFT = 8, MAXREL = 256, RELW = 2 * MAXREL + 1;
constexpr int NE = 32, TOPK = 4, FF = 1024;
constexpr int INW = 3592, PJ = 3584;
constexpr int QA = 0, KA = 512, VA = 1024, ZA = 1536, QB = 2048, KB = 2560, VB = 3072;
constexpr float EPS = 1e-6f;
constexpr int NSLOT = M * TOPK;

typedef __bf16 bf16x2h_t __attribute__((ext_vector_type(2)));
__device__ __forceinline__ unsigned pk2(float lo, float hi) { f32x2 v = {lo, hi}; bf16x2h_t b = __builtin_convertvector(v, bf16x2h_t); return __builtin_bit_cast(unsigned, b); }
__device__ __forceinline__ unsigned f2bf(float f) { return pk2(f, 0.f) & 0xffffu; }
__device__ __forceinline__ float bf2f(unsigned short b) { return __builtin_bit_cast(float, (unsigned)b << 16); }
__device__ __forceinline__ float bflo(unsigned w) { return __builtin_bit_cast(float, w << 16); }
__device__ __forceinline__ float bfhi(unsigned w) { return __builtin_bit_cast(float, w & 0xffff0000u); }
__device__ __forceinline__ float wave_sum(float v) {
#pragma unroll
    for (int o = 1; o < 64; o <<= 1) v += __shfl_xor(v, o);
    return v;
}
__device__ __forceinline__ float sigmoidf_(float x) { return __builtin_amdgcn_rcpf(1.0f + __builtin_amdgcn_exp2f(x * -1.4426950408889634f)); }
__device__ __forceinline__ float siluf_(float x) { return x * sigmoidf_(x); }
#define LDS_WAIT() asm volatile("s_waitcnt lgkmcnt(0)" ::: "memory")
#define VM_WAIT() asm volatile("s_waitcnt vmcnt(0)" ::: "memory")
namespace pg8 {
constexpr int BM = 256, BK = 64, HALF = 128, HTB = HALF * BK * 2  , STAGE_BYTES = 8 * HTB, NXCD = 8, WGM = 8;

__host__ __device__ __forceinline__ int lds_byte(int r, int c) { const int st = (r >> 4) * 2 + (c >> 5), rr = r & 15, cc = c & 31, ob = rr * 64 + cc * 2; return st * 1024 + (ob ^ (((ob >> 9) & 1) << 5)); }
__host__ __device__ __forceinline__ void stage_rc(int b, int& R, int& C) { const int st = b / 1024, sb = b % 1024, swz = sb ^ (((sb >> 9) & 1) << 5); R = (st >> 1) * 16 + swz / 64; C = (st & 1) * 32 + (swz % 64) / 2; }
__host__ __device__ __forceinline__ int perm32(int rho) { const int n = rho >> 4, i = rho & 15; return 8 * (i >> 2) + 4 * n + (i & 3); }

struct Unit { const char* a; const char* b; int pm, pn, e, row0, nvalid, lrow0; };

__device__ __forceinline__ bool static_tile(int i, int G, int c, int nM, int nN, int& pm, int& pn, int wgm = WGM) {
    const int nwg = nM * nN; const long L = (long)i * G + c; if (L >= nwg) return false;
    int wgid = (int)L; { const int q = nwg / NXCD, r = nwg % NXCD, xcd = wgid % NXCD, off = wgid / NXCD; wgid = (xcd < r ? xcd * (q + 1) : r * (q + 1) + (xcd - r) * q) + off; }
    const int nig = wgm * nN, gid = wgid / nig, fm = gid * wgm, gsz = (nM - fm) < wgm ? (nM - fm) : wgm;
    pm = fm + ((wgid % nig) % gsz); pn = (wgid % nig) / gsz; return true;
}
struct DenseOrder {
    const char* A; const char* Bt; int nM, nN, K, G, c;
    __device__ __forceinline__ bool next(int i, Unit& u) const {
        int pm, pn; if (!static_tile(i, G, c, nM, nN, pm, pn)) return false;
        u.pm = pm; u.pn = pn; u.e = 0; u.row0 = pm * BM; u.nvalid = BM; u.lrow0 = 0;
        u.a = A + (size_t)pm * BM * K * 2; u.b = Bt + (size_t)pn * BM * K * 2; return true;
    }
};

typedef __bf16 bf16x2v_t __attribute__((ext_vector_type(2)));
__device__ __forceinline__ unsigned cvt_pk_bf16(float lo, float hi) { f32x2 v = {lo, hi}; bf16x2v_t b = __builtin_convertvector(v, bf16x2v_t); return __builtin_bit_cast(unsigned, b); }


template <class Epi, class Sched, bool GATHER, bool ALIGN_EPI>
__device__ __forceinline__ void gemm_phase(LAS unsigned char* lds, const int K, const Sched& S, const Epi& E, const char* gbase, const int* gidx) {
    int tid_ = threadIdx.x; asm volatile("" : "+v"(tid_));
    const int tid = tid_, wid = __builtin_amdgcn_readfirstlane(tid >> 6), lane = tid & 63, wr = wid >> 2, wc = wid & 3, fr = lane & 15, fq = lane >> 4;
    const int nt = K / BK;
    unsigned voffA[2], voffB[2]; int Rr[2]; unsigned colb[2];
#pragma unroll
    for (int i = 0; i < 2; ++i) { int R, C; stage_rc(tid * 16 + i * 8192, R, C); const int Rb = Epi::PERM ? ((R & ~31) + perm32(R & 31)) : R;
        voffA[i] = (unsigned)(R * K + C) * 2u; voffB[i] = (unsigned)(Rb * K + C) * 2u; Rr[i] = R; colb[i] = (unsigned)C * 2u; }
    const size_t kstep = (size_t)(BK * 2);
    const size_t hstep = (size_t)HALF * K * 2;
    const unsigned ldsw = (unsigned)wid * 1024u;
    const int aoff = lds_byte(wr * 64 + fr, fq * 8), boff = lds_byte(wc * 32 + fr, fq * 8);
    unsigned cg[2][2] = {{0u, 0u}, {0u, 0u}}, ng[2][2] = {{0u, 0u}, {0u, 0u}};
#define PG8_SA(b, h) (((b) * 2 + (h)) * HTB)
#define PG8_SB(b, h) ((4 + (b) * 2 + (h)) * HTB)
#define PG8_GLDS(src, bufoff, i_) __builtin_amdgcn_global_load_lds((const unsigned*)(src), (LAS unsigned*)(lds + (bufoff) + ldsw + (i_) * 8192), 16, 0, 0)
#define PG8_STAGE_B(bufoff, gb) do { _Pragma("unroll") for (int _i = 0; _i < 2; ++_i) PG8_GLDS((const char*)(gb) + voffB[_i], bufoff, _i); } while (0)
#define PG8_STAGE_A(bufoff, pbase, kofs, half, GO) do { _Pragma("unroll") for (int _i = 0; _i < 2; ++_i) { \
        if constexpr (GATHER) PG8_GLDS(gbase + (kofs) + GO[half][_i], bufoff, _i); \
        else PG8_GLDS((pbase) + ((half) ? hstep : (size_t)0) + voffA[_i], bufoff, _i); } } while (0)
#define PG8_LDA(dst, b, h) do { _Pragma("unroll") for (int m = 0; m < 4; ++m) _Pragma("unroll") for (int k = 0; k < 2; ++k) dst[m][k] = *(const LAS bf16x8*)(lds + PG8_SA(b, h) + aoff + m * 2048 + k * 1024); } while (0)
#define PG8_LDB(dst, b, h) do { _Pragma("unroll") for (int n = 0; n < 2; ++n) _Pragma("unroll") for (int k = 0; k < 2; ++k) dst[n][k] = *(const LAS bf16x8*)(lds + PG8_SB(b, h) + boff + n * 2048 + k * 1024); } while (0)
#define PG8_MMA(ai, bj, At, Bt) do { __builtin_amdgcn_s_setprio(1); _Pragma("unroll") for (int m = 0; m < 4; ++m) _Pragma("unroll") for (int n = 0; n < 2; ++n) _Pragma("unroll") for (int k = 0; k < 2; ++k) \
        acc[ai][bj][m][n] = __builtin_amdgcn_mfma_f32_16x16x32_bf16(Bt[n][k], At[m][k], acc[ai][bj][m][n], 0, 0, 0); __builtin_amdgcn_s_setprio(0); } while (0)
#define PG8_WAIT_V(n) asm volatile("s_waitcnt vmcnt(" #n ")" ::: "memory")
#define PG8_WAIT_L(n) asm volatile("s_waitcnt lgkmcnt(" #n ")" ::: "memory")
#define PG8_BAR __builtin_amdgcn_s_barrier()
#define PG8_SCHED __builtin_amdgcn_sched_barrier(0)
#define PG8_LOADG(u_, G_) do { _Pragma("unroll") for (int _h = 0; _h < 2; ++_h) _Pragma("unroll") for (int _i = 0; _i < 2; ++_i) { \
        const int _t = (gidx[(u_).lrow0 + _h * HALF + Rr[_i]] >> 2) & (M - 1); G_[_h][_i] = (unsigned)_t * (unsigned)(K * 2) + colb[_i]; } } while (0)
    Unit cur, nxt; int ui = 0;
    if (!S.next(0, cur)) return;
    f32x4 acc[2][2][4][2];
#pragma unroll
    for (int a = 0; a < 2; ++a)
#pragma unroll
        for (int b = 0; b < 2; ++b)
#pragma unroll
            for (int m = 0; m < 4; ++m)
#pragma unroll
                for (int n = 0; n < 2; ++n) acc[a][b][m][n] = (f32x4){0.f, 0.f, 0.f, 0.f};
    bf16x8 At[4][2], B0[2][2], B1[2][2];
    const char* cA = cur.a; const char* cB = cur.b;
    if constexpr (GATHER) { PG8_LOADG(cur, cg); }
    PG8_STAGE_B(PG8_SB(0, 0), cB); PG8_STAGE_B(PG8_SB(0, 1), cB + hstep); PG8_STAGE_A(PG8_SA(0, 0), cA, 0, 0, cg); PG8_STAGE_A(PG8_SA(0, 1), cA, 0, 1, cg);
    if (wr == 1) PG8_BAR;
    PG8_WAIT_V(2); PG8_BAR;
    PG8_STAGE_B(PG8_SB(1, 0), cB + kstep); PG8_STAGE_A(PG8_SA(1, 0), cA + kstep, kstep, 0, cg); PG8_STAGE_B(PG8_SB(1, 1), cB + hstep + kstep);
    PG8_WAIT_V(6); PG8_BAR;
    for (;;) {
        const bool has_next = S.next(ui + 1, nxt);
        const char* nA = has_next ? nxt.a : cA; const char* nB = has_next ? nxt.b : cB;
        LAS int* tls = (LAS int*)(lds + STAGE_BYTES + ((ui + 1) & 1) * 1024);
        LAS unsigned char* eps = lds + STAGE_BYTES + 2048 + (ui & 1) * 3072;
        if (wid == 4) E.prefetch(cur, eps, lane);
        if constexpr (GATHER) {
            if (has_next && wid == 0) { int l_ = lane; asm volatile("" : "+v"(l_)); __builtin_amdgcn_global_load_lds((const unsigned*)(gidx + nxt.lrow0 + l_ * 4), (LAS unsigned*)tls, 16, 0, 0); }
        }
        for (int t = 0; t < nt; t += 2) {
            const bool last = (t == nt - 2);
            const size_t k1 = (size_t)(t + 1) * kstep, k2 = last ? (size_t)0 : (size_t)(t + 2) * kstep, k3 = k2 + kstep;
            const char* a1 = cA + k1;
            const char* a2 = last ? nA : cA + k2; const char* b2 = last ? nB : cB + k2;
            const char* a3 = a2 + kstep; const char* b3 = b2 + kstep;
            if constexpr (GATHER) { if (t == nt - 4) {
#pragma unroll
                for (int h = 0; h < 2; ++h)
#pragma unroll
                    for (int i = 0; i < 2; ++i) { const int tk = (tls[h * HALF + Rr[i]] >> 2) & (M - 1); ng[h][i] = has_next ? (unsigned)tk * (unsigned)(K * 2) + colb[i] : cg[h][i]; } } }
            unsigned xg[2][2];
#pragma unroll
            for (int h = 0; h < 2; ++h)
#pragma unroll
                for (int i = 0; i < 2; ++i) xg[h][i] = last ? ng[h][i] : cg[h][i];
            PG8_LDB(B0, 0, 0); PG8_LDB(B1, 0, 1); PG8_SCHED; PG8_LDA(At, 0, 0); PG8_STAGE_A(PG8_SA(1, 1), a1, k1, 1, cg);
            PG8_WAIT_V(8); PG8_WAIT_L(0); PG8_BAR; PG8_MMA(0, 0, At, B0); PG8_MMA(0, 1, At, B1); PG8_BAR; PG8_SCHED;
            PG8_LDA(At, 0, 1); PG8_STAGE_B(PG8_SB(0, 0), b2); PG8_STAGE_B(PG8_SB(0, 1), b2 + hstep); PG8_STAGE_A(PG8_SA(0, 0), a2, k2, 0, xg);
            PG8_WAIT_V(8); PG8_WAIT_L(0); PG8_BAR; PG8_MMA(1, 0, At, B0); PG8_MMA(1, 1, At, B1); PG8_BAR; PG8_SCHED;
            PG8_LDB(B0, 1, 0); PG8_LDB(B1, 1, 1); PG8_SCHED; PG8_LDA(At, 1, 0); PG8_STAGE_A(PG8_SA(0, 1), a2, k2, 1, xg);
            PG8_WAIT_V(8); PG8_WAIT_L(0); PG8_BAR; PG8_MMA(0, 0, At, B0); PG8_MMA(0, 1, At, B1); PG8_BAR; PG8_SCHED;
            PG8_LDA(At, 1, 1); PG8_STAGE_B(PG8_SB(1, 0), b3); PG8_STAGE_B(PG8_SB(1, 1), b3 + hstep); PG8_STAGE_A(PG8_SA(1, 0), a3, k3, 0, xg);
            PG8_WAIT_V(8); PG8_WAIT_L(0); PG8_BAR; PG8_MMA(1, 0, At, B0); PG8_MMA(1, 1, At, B1); PG8_BAR; PG8_SCHED;
        }
        if constexpr (ALIGN_EPI) { if (wr == 0) PG8_BAR; }
        E(acc, cur, wr, wc, fr, fq, eps);
        if (!has_next) break;
#pragma unroll
        for (int a = 0; a < 2; ++a)
#pragma unroll
            for (int b = 0; b < 2; ++b)
#pragma unroll
                for (int m = 0; m < 4; ++m)
#pragma unroll
                    for (int n = 0; n < 2; ++n) acc[a][b][m][n] = (f32x4){0.f, 0.f, 0.f, 0.f};
        cur = nxt; cA = nA; cB = nB; ++ui;
        if constexpr (GATHER) {
#pragma unroll
            for (int h = 0; h < 2; ++h)
#pragma unroll
                for (int i = 0; i < 2; ++i) cg[h][i] = ng[h][i];
        }
        if constexpr (ALIGN_EPI) { if (wr == 1) PG8_BAR; }
    }
    PG8_WAIT_V(0);
    if constexpr (!ALIGN_EPI) { if (wr == 0) PG8_BAR; }
    PG8_BAR;
#undef PG8_SA
#undef PG8_SB
#undef PG8_GLDS
#undef PG8_STAGE_A
#undef PG8_STAGE_B
#undef PG8_LDA
#undef PG8_LDB
#undef PG8_MMA
#undef PG8_WAIT_V
#undef PG8_WAIT_L
#undef PG8_BAR
#undef PG8_SCHED
#undef PG8_LOADG
}
}
namespace pg8 {
struct EpiProj {
    static constexpr bool PERM = true;
    bf16_t* O; int ldc;
    __device__ __forceinline__ void prefetch(const Unit&, LAS unsigned char*, int) const {}
    __device__ __forceinline__ void operator()(const f32x4 (&acc)[2][2][4][2], const Unit& u, int wr, int wc, int fr, int fq, const LAS unsigned char*) const {
        const int row0 = u.row0 + wr * 64 + fr, col0 = u.pn * BM + wc * 32 + 8 * fq;
#pragma unroll
        for (int ai = 0; ai < 2; ++ai)
#pragma unroll
            for (int m = 0; m < 4; ++m) { bf16_t* rowp = O + (size_t)(row0 + ai * HALF + m * 16) * ldc + col0;
#pragma unroll
                for (int bj = 0; bj < 2; ++bj) { const f32x4 v0 = acc[ai][bj][m][0], v1 = acc[ai][bj][m][1];
                    u32x4 w; w.x = cvt_pk_bf16(v0[0], v0[1]); w.y = cvt_pk_bf16(v0[2], v0[3]); w.z = cvt_pk_bf16(v1[0], v1[1]); w.w = cvt_pk_bf16(v1[2], v1[3]);
                    *(u32x4*)(rowp + bj * HALF) = w; } }
    }
};
struct EpiResid {
    static constexpr bool PERM = false;
    const float* base; float* out; int ldc;
    __device__ __forceinline__ void prefetch(const Unit&, LAS unsigned char*, int) const {}
    __device__ __forceinline__ void operator()(const f32x4 (&acc)[2][2][4][2], const Unit& u, int wr, int wc, int fr, int fq, const LAS unsigned char*) const {
        const int row0 = u.row0 + wr * 64 + fr, col0 = u.pn * BM + wc * 32 + 4 * fq;
#pragma unroll
        for (int ai = 0; ai < 2; ++ai)
#pragma unroll
        for (int mp = 0; mp < 2; ++mp) {
            f32x4 bs[2][2][2];
#pragma unroll
            for (int mm = 0; mm < 2; ++mm) { const size_t off = (size_t)(row0 + ai * HALF + (2 * mp + mm) * 16) * ldc + col0;
#pragma unroll
                for (int bj = 0; bj < 2; ++bj)
#pragma unroll
                    for (int n = 0; n < 2; ++n) bs[mm][bj][n] = *(const f32x4*)(base + off + bj * HALF + n * 16); }
#pragma unroll
            for (int mm = 0; mm < 2; ++mm) { const size_t off = (size_t)(row0 + ai * HALF + (2 * mp + mm) * 16) * ldc + col0;
#pragma unroll
                for (int bj = 0; bj < 2; ++bj)
#pragma unroll
                    for (int n = 0; n < 2; ++n) *(f32x4*)(out + off + bj * HALF + n * 16) = bs[mm][bj][n] + acc[ai][bj][2 * mp + mm][n]; } }
    }
};
struct EpiSwiglu {
    static constexpr bool PERM = true;
    bf16_t* ACT; const float* bg; const float* bu;
    const float* rsc;
    __device__ __forceinline__ void prefetch(const Unit& u, LAS unsigned char* ep, int lane) const {
        asm volatile("" : "+v"(lane));
        __builtin_amdgcn_global_load_lds((const unsigned*)(rsc + u.lrow0 + lane * 4), (LAS unsigned*)ep, 16, 0, 0);
        const float* bsrc = ((lane < 32) ? bg : bu) + (size_t)u.e * FF + u.pn * HALF + (lane & 31) * 4;
        __builtin_amdgcn_global_load_lds((const unsigned*)bsrc, (LAS unsigned*)(ep + 1024), 16, 0, 0);
    }
    __device__ __forceinline__ void operator()(const f32x4 (&acc)[2][2][4][2], const Unit& u, int wr, int wc, int fr, int fq, const LAS unsigned char* ep) const {
        const int fcol = u.pn * HALF + wc * 32 + 8 * fq;
        const LAS float* pg = (const LAS float*)(ep + 1024) + wc * 32 + 8 * fq; const LAS float* pu = pg + 128;
        const f32x4 g0 = *(const LAS f32x4*)pg, g1 = *(const LAS f32x4*)(pg + 4), u0 = *(const LAS f32x4*)pu, u1 = *(const LAS f32x4*)(pu + 4);
        float rsa[2][4];
#pragma unroll
        for (int ai = 0; ai < 2; ++ai)
#pragma unroll
            for (int m = 0; m < 4; ++m) rsa[ai][m] = ((const LAS float*)ep)[ai * HALF + wr * 64 + m * 16 + fr];
#pragma unroll
        for (int ai = 0; ai < 2; ++ai)
#pragma unroll
            for (int m = 0; m < 4; ++m) { const int r = ai * HALF + wr * 64 + m * 16 + fr;
                const float rsv = rsa[ai][m];
                float o[8];
#pragma unroll
                for (int n = 0; n < 2; ++n)
#pragma unroll
                    for (int c = 0; c < 4; ++c) {
                        float gt = acc[ai][0][m][n][c] * rsv + (n ? g1[c] : g0[c]); float up = acc[ai][1][m][n][c] * rsv + (n ? u1[c] : u0[c]);
                        gt = fminf(gt, 7.0f); up = fminf(fmaxf(up, -7.0f), 7.0f);
                        const float sg = __builtin_amdgcn_rcpf(1.0f + __builtin_amdgcn_exp2f(gt * (-1.702f * 1.4426950408889634f)));
                        o[n * 4 + c] = (up + 1.0f) * (gt * sg); }
                if (r < u.nvalid) { u32x4 w; w.x = cvt_pk_bf16(o[0], o[1]); w.y = cvt_pk_bf16(o[2], o[3]); w.z = cvt_pk_bf16(o[4], o[5]); w.w = cvt_pk_bf16(o[6], o[7]);
                    *(u32x4*)(ACT + (size_t)(u.row0 + r) * FF + fcol) = w; } }
    }
};
struct EpiDown {
    static constexpr bool PERM = true;
    bf16_t* Y01; bf16_t* Y23; const float* bd; const int* meta; const float* gate;
    __device__ __forceinline__ void prefetch(const Unit& u, LAS unsigned char* ep, int lane) const {
        asm volatile("" : "+v"(lane));
        __builtin_amdgcn_global_load_lds((const unsigned*)(meta + u.lrow0 + lane * 4), (LAS unsigned*)ep, 16, 0, 0);
        __builtin_amdgcn_global_load_lds((const unsigned*)(gate + u.lrow0 + lane * 4), (LAS unsigned*)(ep + 1024), 16, 0, 0);
        __builtin_amdgcn_global_load_lds((const unsigned*)(bd + (size_t)u.e * D + u.pn * BM + lane * 4), (LAS unsigned*)(ep + 2048), 16, 0, 0);
    }
    __device__ __forceinline__ void operator()(const f32x4 (&acc)[2][2][4][2], const Unit& u, int wr, int wc, int fr, int fq, const LAS unsigned char* ep) const {
        const int col0 = u.pn * BM + wc * 32 + 8 * fq;
        f32x4 bv[2][2];
#pragma unroll
        for (int bj = 0; bj < 2; ++bj)
#pragma unroll
            for (int n = 0; n < 2; ++n) bv[bj][n] = *(const LAS f32x4*)(ep + 2048 + (wc * 32 + 8 * fq + bj * HALF + 4 * n) * 4);
#pragma unroll
        for (int ai = 0; ai < 2; ++ai) {
            int mt[4]; float gw[4];
#pragma unroll
            for (int m = 0; m < 4; ++m) { const int r = ai * HALF + wr * 64 + m * 16 + fr; const bool ok = r < u.nvalid;
                const int mv_ = ((const LAS int*)ep)[r]; const float gv_ = ((const LAS float*)(ep + 1024))[r];
                mt[m] = ok ? mv_ : -1; gw[m] = ok ? gv_ : 0.f; }
#pragma unroll
            for (int m = 0; m < 4; ++m) { const int mv = mt[m]; if (mv >= 0) { const int tok = mv >> 2, kk = mv & 3; const float g = gw[m];
                const unsigned yo = ((unsigned)tok * 2u + (unsigned)(kk & 1)) * (unsigned)D + (unsigned)col0;
#pragma unroll
                for (int bj = 0; bj < 2; ++bj) {
                    const f32x4 v0 = (acc[ai][bj][m][0] + bv[bj][0]) * g, v1 = (acc[ai][bj][m][1] + bv[bj][1]) * g;
                    u32x4 w; w.x = cvt_pk_bf16(v0[0], v0[1]); w.y = cvt_pk_bf16(v0[2], v0[3]); w.z = cvt_pk_bf16(v1[0], v1[1]); w.w = cvt_pk_bf16(v1[2], v1[3]);
                    if (kk & 2) *(u32x4*)(Y23 + yo + bj * HALF) = w; else *(u32x4*)(Y01 + yo + bj * HALF) = w; } } } }
    }
};
}
constexpr size_t MiB = 1u << 20;
constexpr size_t WS_CTL = 0, CTL_ZERO_BYTES = 1 * MiB;
constexpr size_t WS_BA = 1 * MiB;
constexpr size_t WS_WINT = 6 * MiB;
constexpr size_t WS_WOT = 13 * MiB;
constexpr size_t WS_XN = 16 * MiB;
constexpr size_t WS_PROJ = 80 * MiB;
constexpr size_t WS_DNBUF = 304 * MiB;
constexpr size_t WS_WGU = 6 * MiB;
constexpr size_t WS_H2 = 134 * MiB;
constexpr size_t WS_WD = 198 * MiB;
constexpr size_t WS_ACT = 262 * MiB;
constexpr size_t WS_LMETA = 518 * MiB + 512 * 1024;
constexpr size_t WS_LGATE = 522 * MiB + 512 * 1024;
constexpr size_t WS_LRS = 526 * MiB + 512 * 1024;
constexpr size_t WS_END = 530 * MiB + 512 * 1024;
static_assert(WS_LRS + (size_t)NE * M * 4 <= WS_END && WS_LGATE + (size_t)NE * M * 4 <= WS_LRS && WS_LMETA + (size_t)NE * M * 4 <= WS_LGATE, "ws map D");
static_assert(WS_ACT + (size_t)(NSLOT + 256) * FF * 2 <= WS_LMETA, "ws map C");
static_assert(WS_XN + (size_t)M * D * 2 <= WS_PROJ && WS_PROJ + (size_t)M * PJ * 2 <= WS_DNBUF, "ws map A");
static_assert(WS_WGU + (size_t)NE * 2 * FF * D * 2 <= WS_H2 && WS_H2 + (size_t)M * D * 2 <= WS_WD && WS_WD + (size_t)NE * D * FF * 2 <= WS_ACT, "ws map B");

constexpr int CW_BAR = 4096;
constexpr int CW_QUEUE = 16384;
constexpr int CW_ECNT = 20480;

constexpr int RING_OFF = 0, RING_BYTES = 147456;
constexpr int LDSCTL_OFF = RING_BYTES, MISC_OFF = LDSCTL_OFF + 320;
constexpr int SMALL_OFF = RING_BYTES + 1024;
constexpr int LDS_BYTES = 163840;
constexpr int NWAVES = 8;

#define RLX_AGENT __ATOMIC_RELAXED, __HIP_MEMORY_SCOPE_AGENT
#define XB_TMO      128
#define XB_XCNT(j)  (256  + 64 * (j))
#define XB_XSUB(j)  (1280 + 64 * (j))
#define XB_XGEN(j)  (2304 + 64 * (j))
#define XB_TOP      3328
#define XB_TOPGEN   3392
#define XCD_BAR_WORDS 3456
#define XB_SPIN_CAP (1u << 22)

__device__ __forceinline__ unsigned xb_ld(unsigned* p)              { return __hip_atomic_load(p, __ATOMIC_RELAXED, __HIP_MEMORY_SCOPE_AGENT); }
__device__ __forceinline__ unsigned xb_add(unsigned* p, unsigned v) { return __hip_atomic_fetch_add(p, v, __ATOMIC_RELAXED, __HIP_MEMORY_SCOPE_AGENT); }
__device__ __forceinline__ unsigned xb_xcc_id() { return (unsigned)__builtin_amdgcn_s_getreg((3 << 11) | 20) & 0xFu; }
#define XB_SPIN(cond, bar) do { unsigned _sp = 0; while (cond) { __builtin_amdgcn_s_sleep(1); \
    if ((++_sp & 255u) == 0u) { if (xb_ld(&(bar)[XB_TMO])) break; if (_sp > XB_SPIN_CAP) { atomicAdd(&(bar)[XB_TMO], 1u); break; } } } } while (0)

struct XcdBarrier { unsigned* bar; unsigned x; volatile LAS unsigned* st; };

__device__ __forceinline__ XcdBarrier xcd_barrier_post(unsigned* bar, volatile LAS unsigned* st) {
    XcdBarrier b; b.bar = bar; b.x = xb_xcc_id(); b.st = st;
    if (threadIdx.x == 0) (void)xb_add(&bar[XB_XCNT(b.x)], 1u);
    return b;
}
__device__ __forceinline__ void xcd_barrier_complete(unsigned* bar, unsigned x, unsigned& nloc, unsigned& nx) {
    const unsigned G = gridDim.x * gridDim.y * gridDim.z;
    unsigned sum, cnt, mine, sp = 0u;
    for (;;) {
        sum = 0u; cnt = 0u; mine = 0u;
#pragma unroll
        for (unsigned j = 0; j < 16; ++j) { const unsigned c = xb_ld(&bar[XB_XCNT(j)]); sum += c; cnt += (c > 0u) ? 1u : 0u; mine = (j == x) ? c : mine; }
        if (sum == G) break;
        __builtin_amdgcn_s_sleep(1);
        if ((++sp & 255u) == 0u) { if (xb_ld(&bar[XB_TMO])) break; if (sp > XB_SPIN_CAP) { atomicAdd(&bar[XB_TMO], 1u); break; } }
    }
    nloc = mine > 0u ? mine : 1u; nx = cnt > 0u ? cnt : 1u;
}
__device__ __forceinline__ void xcd_barrier(const XcdBarrier& b) {
    asm volatile("s_waitcnt vmcnt(0)" ::: "memory");
    __syncthreads();
    if (threadIdx.x == 0) {
        unsigned* bar = b.bar;
        __builtin_amdgcn_s_waitcnt(0);
        unsigned nloc = b.st[0], nx = b.st[1];
        if (nloc == 0u) { xcd_barrier_complete(bar, b.x, nloc, nx); b.st[0] = nloc; b.st[1] = nx; }
        const unsigned old = xb_add(&bar[XB_XSUB(b.x)], 1u);
        const unsigned gen = old / nloc;
        if (old + 1u == (gen + 1u) * nloc) {
            __builtin_amdgcn_fence(__ATOMIC_RELEASE, "agent");
            asm volatile("s_waitcnt vmcnt(0)" ::: "memory");
            const unsigned og = xb_add(&bar[XB_TOP], 1u);
            if (og + 1u == (gen + 1u) * nx) xb_add(&bar[XB_TOPGEN], 1u);
        }
        XB_SPIN(xb_ld(&bar[XB_TOPGEN]) == gen, bar);
        __builtin_amdgcn_fence(__ATOMIC_ACQUIRE, "agent");
        asm volatile("s_waitcnt vmcnt(0)" ::: "memory");
    }
    __syncthreads();
}

struct Args { const float* in[20]; float* out; unsigned char* ws; int ph_lo, ph_hi; };
struct Frame {
    LAS unsigned char* lds; volatile LAS unsigned* MISC; gu32* ctl;
    int tid, lane, wave, vcu, G;
};
__device__ __forceinline__ void transpose_item(const float* W, int K, int N, int k0, int n_src0, bf16_t* WT, int dst_row0, float scale, LAS float* scr, int lane, const float* kscale = nullptr) {
    { f32x4 wv4[8];
#pragma unroll
      for (int i = 0; i < 8; ++i) wv4[i] = *(const f32x4*)(W + (size_t)(k0 + 8 * i + (lane >> 3)) * N + n_src0 + 4 * (lane & 7));
#pragma unroll
      for (int i = 0; i < 8; ++i) { LAS float* d = scr + (8 * i + (lane >> 3)) * 33 + 4 * (lane & 7); const float ks = kscale ? kscale[k0 + 8 * i + (lane >> 3)] : 1.0f;
          d[0] = wv4[i].x * ks; d[1] = wv4[i].y * ks; d[2] = wv4[i].z * ks; d[3] = wv4[i].w * ks; } }
    LDS_WAIT(); asm volatile("" ::: "memory");
    const int c = lane & 7;
#pragma unroll
    for (int j = 0; j < 4; ++j) { const int n = (lane >> 3) + 8 * j; const LAS float* s = scr + (8 * c) * 33 + n;
        u32x4 o; o.x = pk2(s[0 * 33] * scale, s[1 * 33] * scale); o.y = pk2(s[2 * 33] * scale, s[3 * 33] * scale); o.z = pk2(s[4 * 33] * scale, s[5 * 33] * scale); o.w = pk2(s[6 * 33] * scale, s[7 * 33] * scale);
        *(GAS u32x4*)(WT + (size_t)(dst_row0 + n) * K + k0 + 8 * c) = o; }
    LDS_WAIT(); asm volatile("" ::: "memory");
}

__device__ __forceinline__ void tr_load(f32x4 (&wv4)[8], const float* W, int N, int k0, int n_src0, int lane) {
#pragma unroll
    for (int i = 0; i < 8; ++i) wv4[i] = *(const f32x4*)(W + (size_t)(k0 + 8 * i + (lane >> 3)) * N + n_src0 + 4 * (lane & 7));
}
__device__ __forceinline__ void tr_store(const f32x4 (&wv4)[8], int K, int k0, bf16_t* WT, int dst_row0, LAS float* scr, int lane, const float* kscale) {
#pragma unroll
    for (int i = 0; i < 8; ++i) { LAS float* d = scr + (8 * i + (lane >> 3)) * 33 + 4 * (lane & 7); const float ks = kscale ? kscale[k0 + 8 * i + (lane >> 3)] : 1.0f;
        d[0] = wv4[i].x * ks; d[1] = wv4[i].y * ks; d[2] = wv4[i].z * ks; d[3] = wv4[i].w * ks; }
    LDS_WAIT(); asm volatile("" ::: "memory");
    const int c = lane & 7;
#pragma unroll
    for (int j = 0; j < 4; ++j) { const int n = (lane >> 3) + 8 * j; const LAS float* s = scr + (8 * c) * 33 + n;
        u32x4 o; o.x = pk2(s[0 * 33], s[1 * 33]); o.y = pk2(s[2 * 33], s[3 * 33]); o.z = pk2(s[4 * 33], s[5 * 33]); o.w = pk2(s[6 * 33], s[7 * 33]);
        *(GAS u32x4*)(WT + (size_t)(dst_row0 + n) * K + k0 + 8 * c) = o; }
    LDS_WAIT(); asm volatile("" ::: "memory");
}

__device__ __forceinline__ void p0_prologue(Frame& F, const Args& a) {
    LAS float* scr = (LAS float*)(F.lds + RING_OFF + F.wave * 16384);
    const int gw = F.vcu * NWAVES + F.wave, NGW = F.G * NWAVES;
    bf16_t* WinT = (bf16_t*)(a.ws + WS_WINT); bf16_t* WoT = (bf16_t*)(a.ws + WS_WOT);
    constexpr int I_IN = (D / 64) * (PJ / 32), I_O = (D / 64) * (D / 32);
    for (int it = gw; it < I_IN + I_O; it += NGW) {
        if (it < I_IN) { const int nb = it % (PJ / 32), kb = it / (PJ / 32), n0 = 32 * nb;
            transpose_item(a.in[2], D, INW, 64 * kb, n0 + (n0 >= 2048 ? 8 : 0), WinT, n0, (n0 >= QB && n0 < KB) ? 0.125f : 1.0f, scr, F.lane); }
        else { const int r = it - I_IN, nb = r % (D / 32), kb = r / (D / 32);
            transpose_item(a.in[9], D, D, 64 * kb, 32 * nb, WoT, 32 * nb, 1.0f, scr, F.lane); }
    }
    const float* x = a.in[0]; const float* nw = a.in[1]; const float* win = a.in[2];
    __syncthreads();
    LAS float* slab = (LAS float*)(F.lds + RING_OFF);
    for (int i = F.tid; i < D * 8; i += NWAVES * 64) { const int k = i >> 3, c = i & 7; slab[c * D + k] = win[(size_t)k * INW + 2048 + c]; }
    __syncthreads();
    bf16_t* XN = (bf16_t*)(a.ws + WS_XN); float* BA = (float*)(a.ws + WS_BA);
    f32x4 wv[4];
#pragma unroll
    for (int j = 0; j < 4; ++j) wv[j] = *(const f32x4*)(nw + 256 * j + 4 * F.lane);
    f32x4 vn[4];
    if (gw < M) { const f32x4* xr = (const f32x4*)(x + (size_t)gw * D) + F.lane;
#pragma unroll
        for (int j = 0; j < 4; ++j) vn[j] = xr[64 * j]; }
    for (int m = gw; m < M; m += NGW) {
        f32x4 v[4]; float s = 0.f;
#pragma unroll
        for (int j = 0; j < 4; ++j) { v[j] = vn[j]; s += (v[j].x * v[j].x + v[j].y * v[j].y) + (v[j].z * v[j].z + v[j].w * v[j].w); }
        if (m + NGW < M) { const f32x4* xr = (const f32x4*)(x + (size_t)(m + NGW) * D) + F.lane;
#pragma unroll
            for (int j = 0; j < 4; ++j) vn[j] = xr[64 * j]; }
        const float rs = 1.0f / sqrtf(wave_sum(s) * (1.f / D) + EPS);
        unsigned long long* o8 = (unsigned long long*)(XN + (size_t)m * D) + F.lane;
        float ba[8];
#pragma unroll
        for (int c = 0; c < 8; ++c) ba[c] = 0.f;
#pragma unroll
        for (int j = 0; j < 4; ++j) { v[j] = v[j] * rs * wv[j];
            o8[64 * j] = (unsigned long long)pk2(v[j].x, v[j].y) | ((unsigned long long)pk2(v[j].z, v[j].w) << 32);
#pragma unroll
            for (int c = 0; c < 8; ++c) { const f32x4 wq = *(const LAS f32x4*)(slab + c * D + 256 * j + 4 * F.lane); ba[c] += (v[j].x * wq.x + v[j].y * wq.y) + (v[j].z * wq.z + v[j].w * wq.w); } }
#pragma unroll
        for (int c = 0; c < 8; ++c) ba[c] = wave_sum(ba[c]);
        if (F.lane == 0) { *(f32x4*)(BA + (size_t)m * 8) = (f32x4){ba[0], ba[1], ba[2], ba[3]}; *(f32x4*)(BA + (size_t)m * 8 + 4) = (f32x4){ba[4], ba[5], ba[6], ba[7]}; }
    }
}

__device__ __forceinline__ void p5_convert_experts(Frame& F, const Args& a) {
    LAS float* scr = (LAS float*)(F.lds + RING_OFF + F.wave * 16384);
    const int gw = F.vcu * NWAVES + F.wave, NGW = F.G * NWAVES;
    bf16_t* WGU = (bf16_t*)(a.ws + WS_WGU); bf16_t* WD = (bf16_t*)(a.ws + WS_WD);
    constexpr int I_E = (D / 64) * (FF / 32), NI = NE * 3 * I_E;
#define CV_ITEM(it_) const int e_ = (it_) / (3 * I_E), r_ = (it_) % (3 * I_E), wh_ = r_ / I_E, q_ = r_ % I_E, n0_ = 32 * (q_ % 32), k0_ = 64 * (q_ / 32); \
        const float* src_ = (wh_ == 0 ? a.in[13] : wh_ == 1 ? a.in[15] : a.in[17]) + (size_t)e_ * D * FF
#define CV_LOAD(buf_, it_) do { CV_ITEM(it_); tr_load(buf_, src_, 1024, k0_, n0_, F.lane); } while (0)
#define CV_STORE(buf_, it_) do { CV_ITEM(it_); (void)src_; \
        if (wh_ == 2) tr_store(buf_, 1024, k0_, WD + (size_t)e_ * D * FF, n0_, scr, F.lane, nullptr); \
        else tr_store(buf_, 1024, k0_, WGU + (size_t)e_ * 2 * FF * D, 256 * (n0_ / 128) + (wh_ ? 128 : 0) + (n0_ % 128), scr, F.lane, a.in[10]); } while (0)
    f32x4 b0[8], b1[8];
    int it = gw;
    if (it < NI) CV_LOAD(b0, it);
    for (; it < NI; it += 2 * NGW) {
        if (it + NGW < NI) CV_LOAD(b1, it + NGW);
        CV_STORE(b0, it);
        if (it + NGW < NI) { if (it + 2 * NGW < NI) CV_LOAD(b0, it + 2 * NGW);
            CV_STORE(b1, it + NGW); }
    }
#undef CV_ITEM
#undef CV_LOAD
#undef CV_STORE
}

__device__ __forceinline__ void p5_router(Frame& F, const Args& a) {
    LAS float* Wt = (LAS float*)(F.lds + RING_OFF);
    LAS int* hist = (LAS int*)(F.lds + SMALL_OFF);
    LAS int* gbase = hist + 32; LAS int* asg = hist + 64; LAS float* asgg = (LAS float*)(hist + 64 + 512);
    const float* wr = a.in[11]; const float* br = a.in[12]; const float* nw = a.in[10];
    for (int i = F.tid; i < D * NE; i += NWAVES * 64) { const int k = i >> 5, e = i & 31; Wt[e * D + k] = wr[i]; }
    if (F.tid < NE) hist[F.tid] = 0;
    __syncthreads();
    const float* x2 = a.out; bf16_t* H2 = (bf16_t*)(a.ws + WS_H2);
    f32x4 wv[4];
#pragma unroll
    for (int j = 0; j < 4; ++j) wv[j] = *(const f32x4*)(nw + 256 * j + 4 * F.lane);
    const float myb = br[F.lane & 31];
    const int wg = blockIdx.x;
    f32x4 vn[4];
    { const f32x4* xr0 = (const f32x4*)(x2 + (size_t)(wg * 128 + F.wave * 16) * D) + F.lane;
#pragma unroll
      for (int j = 0; j < 4; ++j) vn[j] = (F.G * 128 == M) ? xr0[64 * j] : (f32x4){0.f, 0.f, 0.f, 0.f}; }
    if (F.G * 128 == M)
    for (int r = 0; r < 16; ++r) {
        const int m = wg * 128 + F.wave * 16 + r;
        f32x4 v[4]; float s = 0.f;
#pragma unroll
        for (int j = 0; j < 4; ++j) { v[j] = vn[j]; s += (v[j].x * v[j].x + v[j].y * v[j].y) + (v[j].z * v[j].z + v[j].w * v[j].w); }
        if (r + 1 < 16) { const f32x4* xr = (const f32x4*)(x2 + (size_t)(m + 1) * D) + F.lane;
#pragma unroll
            for (int j = 0; j < 4; ++j) vn[j] = xr[64 * j]; }
        const float rs = 1.0f / sqrtf(wave_sum(s) * (1.f / D) + EPS);
        unsigned long long* o8 = (unsigned long long*)(H2 + (size_t)m * D) + F.lane;
#pragma unroll
        for (int j = 0; j < 4; ++j) { v[j] = v[j] * rs * wv[j]; o8[64 * j] = (unsigned long long)pk2(v[j].x, v[j].y) | ((unsigned long long)pk2(v[j].z, v[j].w) << 32); }
        float lg[32];
#pragma unroll
        for (int e = 0; e < 32; ++e) { float acc = 0.f;
#pragma unroll
            for (int j = 0; j < 4; ++j) { const f32x4 w = *(const LAS f32x4*)(Wt + e * D + 256 * j + 4 * F.lane); acc += (v[j].x * w.x + v[j].y * w.y) + (v[j].z * w.z + v[j].w * w.w); }
            lg[e] = acc; if ((e & 3) == 3) __builtin_amdgcn_sched_barrier(0); }
#define RS_STAGE(W, BIT) { const bool up_ = (F.lane >> (BIT)) & 1; _Pragma("unroll") for (int i_ = 0; i_ < (W); ++i_) { const float keep_ = up_ ? lg[i_ + (W)] : lg[i_]; const float give_ = up_ ? lg[i_] : lg[i_ + (W)]; lg[i_] = keep_ + __shfl_xor(give_, 1 << (BIT)); } }
        RS_STAGE(16, 4) RS_STAGE(8, 3) RS_STAGE(4, 2) RS_STAGE(2, 1) RS_STAGE(1, 0)
#undef RS_STAGE
        float logit = lg[0] + __shfl_xor(lg[0], 32) + myb;
        int sel_e[4]; float sel_v[4];
        { const int me = F.lane & 31, li = __float_as_int(logit); int rank = 0;
#pragma unroll
          for (int e = 0; e < 32; ++e) { const float le = __int_as_float(__builtin_amdgcn_readlane(li, e)); rank += (le > logit || (le == logit && e < me)) ? 1 : 0; }
#pragma unroll
          for (int k = 0; k < 4; ++k) { const unsigned long long mk = __ballot(rank == k); const int ek = __builtin_ctzll(mk | (1ull << 63)) & 31;
              sel_e[k] = ek; sel_v[k] = __int_as_float(__builtin_amdgcn_readlane(li, ek)); } }
        const float e0 = 1.0f, e1 = __expf(sel_v[1] - sel_v[0]), e2 = __expf(sel_v[2] - sel_v[0]), e3 = __expf(sel_v[3] - sel_v[0]);
        const float inv = 1.0f / (e0 + e1 + e2 + e3);
        if (F.lane == 0) { const int tl = F.wave * 16 + r; const float gg[4] = {e0 * inv, e1 * inv, e2 * inv, e3 * inv};
#pragma unroll
            for (int k = 0; k < 4; ++k) { const int rk = __hip_atomic_fetch_add(&hist[sel_e[k]], 1, __ATOMIC_RELAXED, __HIP_MEMORY_SCOPE_WORKGROUP); asg[tl * 4 + k] = (sel_e[k] << 16) | rk; asgg[tl * 4 + k] = gg[k]; } }
    }
    __syncthreads();
    if (F.tid < NE) gbase[F.tid] = (int)__hip_atomic_fetch_add((unsigned*)(F.ctl + CW_ECNT + F.tid), (unsigned)hist[F.tid], __ATOMIC_RELAXED, __HIP_MEMORY_SCOPE_AGENT);
    __syncthreads();
    if (F.G * 128 == M) { const int av = asg[F.tid], e = av >> 16, pos = gbase[e] + (av & 0xffff);
        ((int*)(a.ws + WS_LMETA))[e * M + pos] = (wg * 128 + (F.tid >> 2)) * 4 + (F.tid & 3); ((float*)(a.ws + WS_LGATE))[e * M + pos] = asgg[F.tid]; }
    __syncthreads();
}

constexpr size_t WS_RS = WS_BA;
__device__ __forceinline__ void p5_router_mfma(Frame& F, const Args& a) {
    LAS float* Wt = (LAS float*)(F.lds + RING_OFF);
    LAS float* lgs = (LAS float*)(F.lds + RING_OFF + 131072 + F.wave * 2048);
    LAS int* hist = (LAS int*)(F.lds + SMALL_OFF);
    LAS int* gbase = hist + 32; LAS int* asg = hist + 64; LAS float* asgg = (LAS float*)(hist + 64 + 512); LAS float* rsl = (LAS float*)(hist + 64 + 1024);
    const float* wr = a.in[11]; const float* br = a.in[12]; const float* nw = a.in[10];
    for (int i = F.tid; i < D * NE; i += NWAVES * 64) Wt[i] = wr[i] * nw[i >> 5];
    if (F.tid < NE) hist[F.tid] = 0;
    __syncthreads();
    const float* x2 = a.out; bf16_t* H2 = (bf16_t*)(a.ws + WS_H2); float* RS = (float*)(a.ws + WS_RS);
    const int wg = blockIdx.x, lane = F.lane, ti = lane & 15, kk = lane >> 4;
    if (F.G * 128 == M) {
        const int t0 = wg * 128 + F.wave * 16;
        const float* xrow = x2 + (size_t)(t0 + ti) * D + 4 * kk; bf16_t* hrow = H2 + (size_t)(t0 + ti) * D + 4 * kk;
        const LAS float* wl = Wt + (4 * kk) * 32 + ti;
        f32x4 acc0 = {0.f, 0.f, 0.f, 0.f}, acc1 = {0.f, 0.f, 0.f, 0.f}; float ssq = 0.f;
#define RT_LOAD(buf_, c0_) do { _Pragma("unroll") for (int q_ = 0; q_ < 8; ++q_) buf_[q_] = *(const f32x4*)(xrow + 16 * ((c0_) + q_)); } while (0)
#define RT_PROC(buf_, c0_) do { _Pragma("unroll") for (int q_ = 0; q_ < 8; ++q_) { const f32x4 xv = buf_[q_]; const int c = (c0_) + q_; \
            ssq += (xv.x * xv.x + xv.y * xv.y) + (xv.z * xv.z + xv.w * xv.w); \
            u32x2 hp; hp.x = pk2(xv.x, xv.y); hp.y = pk2(xv.z, xv.w); *(u32x2*)(hrow + 16 * c) = hp; \
            _Pragma("unroll") for (int s = 0; s < 4; ++s) { const float b0 = wl[(16 * c + s) * 32], b1 = wl[(16 * c + s) * 32 + 16]; \
                acc0 = __builtin_amdgcn_mfma_f32_16x16x4f32(xv[s], b0, acc0, 0, 0, 0); acc1 = __builtin_amdgcn_mfma_f32_16x16x4f32(xv[s], b1, acc1, 0, 0, 0); } } } while (0)
        f32x4 xa[8], xb[8];
        RT_LOAD(xa, 0);
#pragma unroll 1
        for (int cb = 0; cb < 64; cb += 16) {
            RT_LOAD(xb, cb + 8);
            RT_PROC(xa, cb);
            if (cb + 16 < 64) RT_LOAD(xa, cb + 16);
            RT_PROC(xb, cb + 8);
        }
#undef RT_LOAD
#undef RT_PROC
        ssq += __shfl_xor(ssq, 16); ssq += __shfl_xor(ssq, 32);
        const float rs = 1.0f / sqrtf(ssq * (1.f / D) + EPS);
        if (kk == 0) { RS[t0 + ti] = rs; rsl[F.wave * 16 + ti] = rs; }
        LDS_WAIT();
        { const f32x4 rv = *(const LAS f32x4*)(rsl + F.wave * 16 + 4 * kk); const float bb0 = br[ti], bb1 = br[16 + ti];
#pragma unroll
          for (int r = 0; r < 4; ++r) { lgs[ti * 16 + 4 * kk + r] = acc0[r] * rv[r] + bb0; lgs[(16 + ti) * 16 + 4 * kk + r] = acc1[r] * rv[r] + bb1; } }
        LDS_WAIT();
        if (lane < 16) { float v[32];
#pragma unroll
            for (int e = 0; e < 32; ++e) v[e] = lgs[e * 16 + lane];
            int sel_e[4]; float sel_v[4];
#pragma unroll
            for (int k = 0; k < 4; ++k) { float bv = v[0]; int be = 0;
#pragma unroll
                for (int e = 1; e < 32; ++e) { const bool gt = v[e] > bv; bv = gt ? v[e] : bv; be = gt ? e : be; }
                sel_e[k] = be; sel_v[k] = bv;
#pragma unroll
                for (int e = 0; e < 32; ++e) v[e] = (e == be) ? -INFINITY : v[e]; }
            const float e0 = 1.0f, e1 = __expf(sel_v[1] - sel_v[0]), e2 = __expf(sel_v[2] - sel_v[0]), e3 = __expf(sel_v[3] - sel_v[0]);
            const float inv = 1.0f / (e0 + e1 + e2 + e3); const float gg[4] = {e0 * inv, e1 * inv, e2 * inv, e3 * inv};
            const int tl = F.wave * 16 + lane;
#pragma unroll
            for (int k = 0; k < 4; ++k) { const int rk = __hip_atomic_fetch_add(&hist[sel_e[k]], 1, __ATOMIC_RELAXED, __HIP_MEMORY_SCOPE_WORKGROUP); asg[tl * 4 + k] = (sel_e[k] << 16) | rk; asgg[tl * 4 + k] = gg[k]; } }
    }
    __syncthreads();
    if (F.tid < NE) gbase[F.tid] = (int)__hip_atomic_fetch_add((unsigned*)(F.ctl + CW_ECNT + F.tid), (unsigned)hist[F.tid], __ATOMIC_RELAXED, __HIP_MEMORY_SCOPE_AGENT);
    __syncthreads();
    if (F.G * 128 == M) { const int av = asg[F.tid], e = av >> 16, pos = gbase[e] + (av & 0xffff);
        ((int*)(a.ws + WS_LMETA))[e * M + pos] = (wg * 128 + (F.tid >> 2)) * 4 + (F.tid & 3); ((float*)(a.ws + WS_LGATE))[e * M + pos] = asgg[F.tid]; ((float*)(a.ws + WS_LRS))[e * M + pos] = rsl[F.tid >> 2]; }
    __syncthreads();
}

#ifndef MOE_WGM_GU
#define MOE_WGM_GU 8
#endif
struct MoeOrder {
    const LAS int* tab; const char* Abase; const char* Bbase; int nT, nN, G, c; size_t bexp; int rev;
    __device__ __forceinline__ bool next(int i, pg8::Unit& u) const {
        int pm, pn; if (!pg8::static_tile(i, G, c, nT, nN, pm, pn, nN == 8 ? MOE_WGM_GU : 8)) return false;
        if (rev) pm = nT - 1 - pm;
        const int e = __builtin_amdgcn_readfirstlane(tab[100 + pm]);
        const int j = pm - tab[e], cnt = tab[66 + e], rs = tab[33 + e];
        u.pm = pm; u.pn = pn; u.e = e; u.row0 = rs + 256 * j; u.nvalid = (cnt - 256 * j) < 256 ? (cnt - 256 * j) : 256; u.lrow0 = e * M + 256 * j;
        u.a = Abase + (size_t)u.row0 * FF * 2; u.b = Bbase + (size_t)e * bexp + (size_t)pn * 256 * 1024 * 2; return true;
    }
};
__device__ __forceinline__ int moe_tables(Frame& F, const Args& a) {
    LAS int* tab = (LAS int*)(F.lds + SMALL_OFF);
    if (F.tid == 0) { const gu32* CNT = F.ctl + CW_ECNT; int t = 0, r = 0;
        for (int e = 0; e < NE; ++e) { const int c = (int)__hip_atomic_load(CNT + e, __ATOMIC_RELAXED, __HIP_MEMORY_SCOPE_AGENT); tab[e] = t; tab[33 + e] = r; tab[66 + e] = c; t += (c + 255) >> 8; r += c; }
        tab[32] = t; tab[65] = r; }
    __syncthreads();
    const int nT = tab[32];
    for (int mt = F.tid; mt < nT; mt += NWAVES * 64) { int e = 0;
#pragma unroll 1
        for (int q = 1; q < NE; ++q) if (tab[q] <= mt) e = q;
        tab[100 + mt] = e; }
    __syncthreads();
    return nT;
}

__device__ __forceinline__ void p9_final(Frame& F, const Args& a) {
    const int gw = F.vcu * NWAVES + F.wave, NGW = F.G * NWAVES;
    const bf16_t* H2 = (const bf16_t*)(a.ws + WS_H2); const bf16_t* Y01 = (const bf16_t*)a.out; const bf16_t* Y23 = (const bf16_t*)(a.ws + WS_WGU); const float* fw = a.in[19];
    f32x4 wv[4];
#pragma unroll
    for (int j = 0; j < 4; ++j) wv[j] = *(const f32x4*)(fw + 256 * j + 4 * F.lane);
#define P9_LOAD(m_, H_, A_, B_, C_, D_) do { _Pragma("unroll") for (int j = 0; j < 4; ++j) { H_[j] = *((const u32x2*)(H2 + (size_t)(m_) * D) + 64 * j + F.lane); \
            A_[j] = *((const u32x2*)(Y01 + (size_t)(m_) * 2 * D) + 64 * j + F.lane); B_[j] = *((const u32x2*)(Y01 + ((size_t)(m_) * 2 + 1) * D) + 64 * j + F.lane); \
            C_[j] = *((const u32x2*)(Y23 + (size_t)(m_) * 2 * D) + 64 * j + F.lane); D_[j] = *((const u32x2*)(Y23 + ((size_t)(m_) * 2 + 1) * D) + 64 * j + F.lane); } } while (0)
    u32x2 nh[4], n0[4], n1[4], n2[4], n3[4];
    if (gw < M) P9_LOAD(gw, nh, n0, n1, n2, n3);
    for (int m = gw; m < M; m += NGW) {
        u32x2 hv[4], y0[4], y1[4], y2[4], y3[4];
#pragma unroll
        for (int j = 0; j < 4; ++j) { hv[j] = nh[j]; y0[j] = n0[j]; y1[j] = n1[j]; y2[j] = n2[j]; y3[j] = n3[j]; }
        if (m + NGW < M) P9_LOAD(m + NGW, nh, n0, n1, n2, n3);
        f32x4 v[4]; float s = 0.f;
#pragma unroll
        for (int j = 0; j < 4; ++j) {
            v[j].x = bflo(hv[j].x) + ((bflo(y0[j].x) + bflo(y1[j].x)) + (bflo(y2[j].x) + bflo(y3[j].x)));
            v[j].y = bfhi(hv[j].x) + ((bfhi(y0[j].x) + bfhi(y1[j].x)) + (bfhi(y2[j].x) + bfhi(y3[j].x)));
            v[j].z = bflo(hv[j].y) + ((bflo(y0[j].y) + bflo(y1[j].y)) + (bflo(y2[j].y) + bflo(y3[j].y)));
            v[j].w = bfhi(hv[j].y) + ((bfhi(y0[j].y) + bfhi(y1[j].y)) + (bfhi(y2[j].y) + bfhi(y3[j].y)));
            s += (v[j].x * v[j].x + v[j].y * v[j].y) + (v[j].z * v[j].z + v[j].w * v[j].w); }
        const float rs = 1.0f / sqrtf(wave_sum(s) * (1.f / D) + EPS);
        f32x4* xo = (f32x4*)(a.out + (size_t)m * D) + F.lane;
#pragma unroll
        for (int j = 0; j < 4; ++j) xo[64 * j] = v[j] * rs * wv[j];
    }
#undef P9_LOAD
}
typedef float f32x16 __attribute__((ext_vector_type(16)));
typedef short s16x4 __attribute__((ext_vector_type(4)));
typedef __bf16 bf16x2_t __attribute__((ext_vector_type(2)));
__device__ __forceinline__ unsigned cvtpk_s(float lo, float hi) { f32x2 v = {lo, hi}; bf16x2_t b = __builtin_convertvector(v, bf16x2_t); return __builtin_bit_cast(unsigned, b); }
constexpr int ATT_BT = 320;
constexpr int ATT_SM_PER_WAVE = ATT_BT * 4 + 128;
__device__ __forceinline__ s16x4 vtr16(const LAS void* p) { return __builtin_bit_cast(s16x4, __builtin_amdgcn_ds_read_tr16_b64_v4i16((LAS s16x4*)p)); }

__device__ __forceinline__ void attn_item(Frame& F, const Args& a, int item, bf16_t* MIX) {
    const bf16_t* PROJ = (const bf16_t*)(a.ws + WS_PROJ);
    const int lane = F.lane, w = F.wave, hg = item & 1, n = (item >> 1) & 63, b = item >> 7;
    const int h = 4 * hg + (w >> 1), qb = w & 1, r32 = lane & 31, hh = lane >> 5;
    LAS unsigned char* Kb = F.lds + RING_OFF + w * 16384;
    LAS unsigned char* Vb = Kb + 8192;
    LAS float* bt = (LAS float*)(F.lds + SMALL_OFF + w * ATT_SM_PER_WAVE);
    LAS float* bc = bt + ATT_BT;
    constexpr float L2E = 1.4426950408889634f;
    for (int i = lane; i < ATT_BT; i += 64) bt[i] = a.in[7][h * RELW + 193 + i];
    const int t0 = b * SEQ + n * CH;
    bf16x8 qf[4];
    { const bf16_t* qp = PROJ + (size_t)(t0 + 32 * qb + r32) * PJ + QB + h * 64 + 8 * hh;
#pragma unroll
      for (int s = 0; s < 4; ++s) qf[s] = *(const bf16x8*)(qp + 16 * s); }
    f32x16 o0 = {}, o1 = {};
    float mrun = -INFINITY, lrun = 0.f;
    const int jt0 = (CALEFT - n) > 0 ? (CALEFT - n) : 0;
    const unsigned ksrc = ((unsigned)(lane >> 3) * PJ + KB + h * 64 + 8 * ((lane & 7) ^ ((lane >> 3) & 7))) * 2u, vsrc = ((unsigned)(lane >> 3) * PJ + VB + h * 64 + 8 * (lane & 7)) * 2u;
#define ATT_TP(jt_) ((const unsigned char*)(PROJ + (size_t)(b * SEQ + (n - CALEFT + (jt_)) * CH) * PJ))
#define ATT_LOADK(jt_) do { const unsigned char* tp_ = ATT_TP(jt_); _Pragma("unroll") for (int i_ = 0; i_ < 8; ++i_) \
        __builtin_amdgcn_global_load_lds((const unsigned*)(tp_ + (size_t)(8 * i_) * PJ * 2 + ksrc), (LAS unsigned*)(Kb + i_ * 1024), 16, 0, 0); } while (0)
#define ATT_LOADV(jt_) do { const unsigned char* tp_ = ATT_TP(jt_); _Pragma("unroll") for (int i_ = 0; i_ < 8; ++i_) \
        __builtin_amdgcn_global_load_lds((const unsigned*)(tp_ + (size_t)(8 * i_) * PJ * 2 + vsrc), (LAS unsigned*)(Vb + i_ * 1024), 16, 0, 0); } while (0)
    asm volatile("s_waitcnt vmcnt(0) lgkmcnt(0)" : "+v"(qf[0]), "+v"(qf[1]), "+v"(qf[2]), "+v"(qf[3]) :: "memory");
    ATT_LOADK(jt0); ATT_LOADV(jt0);
    const int vrd = (4 * hh + ((lane & 15) >> 2)) * 128 + (16 * ((lane >> 4) & 1) + 4 * (lane & 3)) * 2;
    const int krd = r32 * 128;
    const int qi = 32 * qb + r32;
#pragma unroll 1
    for (int jt = jt0; jt <= CALEFT; ++jt) {
        asm volatile("s_waitcnt vmcnt(8)" ::: "memory");
        bf16x8 kf[2][4];
#pragma unroll
        for (int kb = 0; kb < 2; ++kb)
#pragma unroll
            for (int s = 0; s < 4; ++s) kf[kb][s] = *(const LAS bf16x8*)(Kb + kb * 4096 + krd + (((2 * s + hh) ^ (r32 & 7)) << 4));
        asm volatile("s_waitcnt lgkmcnt(0)" : "+v"(kf[0][0]), "+v"(kf[0][1]), "+v"(kf[0][2]), "+v"(kf[0][3]), "+v"(kf[1][0]), "+v"(kf[1][1]), "+v"(kf[1][2]), "+v"(kf[1][3]) :: "memory");
        if (jt < CALEFT) { ATT_LOADK(jt + 1); } else { ATT_LOADK(jt); }
        f32x16 s0, s1;
        if (jt <= 3) { const float c_ = bt[ATT_BT - 1];
#pragma unroll
            for (int r_ = 0; r_ < 16; ++r_) { s0[r_] = c_; s1[r_] = c_; } }
        else { const int base_ = qi + 512 - 64 * jt - 4 * hh + 63;
#pragma unroll
            for (int r_ = 0; r_ < 16; ++r_) { const int kk_ = (r_ & 3) + 8 * (r_ >> 2); int i0_ = base_ - kk_, i1_ = base_ - 32 - kk_;
                i0_ = i0_ > ATT_BT - 1 ? ATT_BT - 1 : i0_; i1_ = i1_ > ATT_BT - 1 ? ATT_BT - 1 : i1_; s0[r_] = bt[i0_]; s1[r_] = bt[i1_]; } }
#pragma unroll
        for (int s_ = 0; s_ < 4; ++s_) { s0 = __builtin_amdgcn_mfma_f32_32x32x16_bf16(kf[0][s_], qf[s_], s0, 0, 0, 0); s1 = __builtin_amdgcn_mfma_f32_32x32x16_bf16(kf[1][s_], qf[s_], s1, 0, 0, 0); }
        float mx_ = s0[0];
#pragma unroll
        for (int r_ = 1; r_ < 16; ++r_) mx_ = fmaxf(mx_, s0[r_]);
#pragma unroll
        for (int r_ = 0; r_ < 16; ++r_) mx_ = fmaxf(mx_, s1[r_]);
        mx_ = fmaxf(mx_, __shfl_xor(mx_, 32));
        const float mnew_ = fmaxf(mrun, mx_); const float al_ = __builtin_amdgcn_exp2f((mrun - mnew_) * L2E); const float nm_ = -mnew_ * L2E;
        float ps_ = 0.f;
#pragma unroll
        for (int r_ = 0; r_ < 16; ++r_) { s0[r_] = __builtin_amdgcn_exp2f(s0[r_] * L2E + nm_); s1[r_] = __builtin_amdgcn_exp2f(s1[r_] * L2E + nm_); ps_ += s0[r_] + s1[r_]; }
        lrun = lrun * al_ + ps_;
        if (!__all(mnew_ == mrun)) { if (hh == 0) bc[r32] = al_; LDS_WAIT();
#pragma unroll
            for (int g_ = 0; g_ < 4; ++g_) { const f32x4 av_ = *(const LAS f32x4*)(bc + 8 * g_ + 4 * hh);
#pragma unroll
                for (int c_ = 0; c_ < 4; ++c_) { o0[4 * g_ + c_] *= av_[c_]; o1[4 * g_ + c_] *= av_[c_]; } } }
        mrun = mnew_;
        asm volatile("s_waitcnt vmcnt(8)" ::: "memory");
        bf16x8 vf[2][2][2];
#pragma unroll
        for (int kb_ = 0; kb_ < 2; ++kb_)
#pragma unroll
            for (int sp_ = 0; sp_ < 2; ++sp_) {
                const LAS unsigned char* vb_ = Vb + (32 * kb_ + 16 * sp_) * 128 + vrd;
                const s16x4 v00_ = vtr16(vb_), v01_ = vtr16(vb_ + 8 * 128), v10_ = vtr16(vb_ + 64), v11_ = vtr16(vb_ + 8 * 128 + 64);
                vf[kb_][sp_][0] = (bf16x8){v00_[0], v00_[1], v00_[2], v00_[3], v01_[0], v01_[1], v01_[2], v01_[3]};
                vf[kb_][sp_][1] = (bf16x8){v10_[0], v10_[1], v10_[2], v10_[3], v11_[0], v11_[1], v11_[2], v11_[3]}; }
        asm volatile("s_waitcnt lgkmcnt(0)" : "+v"(vf[0][0][0]), "+v"(vf[0][0][1]), "+v"(vf[0][1][0]), "+v"(vf[0][1][1]), "+v"(vf[1][0][0]), "+v"(vf[1][0][1]), "+v"(vf[1][1][0]), "+v"(vf[1][1][1]) :: "memory");
        if (jt < CALEFT) { ATT_LOADV(jt + 1); } else { ATT_LOADV(jt); }
#pragma unroll
        for (int kb_ = 0; kb_ < 2; ++kb_)
#pragma unroll
            for (int sp_ = 0; sp_ < 2; ++sp_) {
                const f32x16& sx_ = kb_ ? s1 : s0;
                u32x4 pw_; pw_.x = cvtpk_s(sx_[8 * sp_ + 0], sx_[8 * sp_ + 1]); pw_.y = cvtpk_s(sx_[8 * sp_ + 2], sx_[8 * sp_ + 3]);
                pw_.z = cvtpk_s(sx_[8 * sp_ + 4], sx_[8 * sp_ + 5]); pw_.w = cvtpk_s(sx_[8 * sp_ + 6], sx_[8 * sp_ + 7]);
                const bf16x8 pa_ = __builtin_bit_cast(bf16x8, pw_);
                o0 = __builtin_amdgcn_mfma_f32_32x32x16_bf16(pa_, vf[kb_][sp_][0], o0, 0, 0, 0); o1 = __builtin_amdgcn_mfma_f32_32x32x16_bf16(pa_, vf[kb_][sp_][1], o1, 0, 0, 0); }
    }
#undef ATT_LOADK
#undef ATT_LOADV
#undef ATT_TP
    asm volatile("s_waitcnt vmcnt(0)" ::: "memory");
    { const float lt = lrun + __shfl_xor(lrun, 32); LDS_WAIT(); if (hh == 0) bc[r32] = 1.0f / lt; LDS_WAIT();
      bf16_t* op = MIX + (size_t)(t0 + 32 * qb) * D + 512 + h * 64 + r32;
#pragma unroll
      for (int g = 0; g < 4; ++g) { const f32x4 av = *(const LAS f32x4*)(bc + 8 * g + 4 * hh);
#pragma unroll
          for (int c = 0; c < 4; ++c) { const int row = 8 * g + 4 * hh + c; op[(size_t)row * D] = (bf16_t)f2bf(o0[4 * g + c] * av[c]); op[(size_t)row * D + 32] = (bf16_t)f2bf(o1[4 * g + c] * av[c]); } }
      LDS_WAIT(); }
}
constexpr size_t WS_DN = WS_DNBUF, DN_ITEM = 98304;
static_assert(WS_DN + (size_t)BATCH * DNH * NCH * DN_ITEM <= WS_END, "ws map DN");
__device__ __forceinline__ f32x4 mfma16(bf16x8 a, bf16x8 b, f32x4 c) { return __builtin_amdgcn_mfma_f32_16x16x32_bf16(a, b, c, 0, 0, 0); }
__device__ __forceinline__ int sw256(int row, int ch) { return row * 256 + ((ch ^ (row & 15)) << 4); }
__device__ __forceinline__ int sw128(int row, int ch) { return row * 128 + ((ch ^ (row & 7)) << 4); }
__device__ __forceinline__ int tr256(int row, int col) { return row * 256 + ((((col >> 4) ^ (row & 7))) << 5) + (col & 15) * 2; }
__device__ __forceinline__ bf16x8 trfrag(const LAS unsigned char* img, int k0, int c0, int lane) {
    const int li = lane & 15, q = li >> 2, p = li & 3, kq = lane >> 4, r0 = k0 + 8 * kq + q;
    const s16x4 x = vtr16(img + tr256(r0, c0 + 4 * p)), y = vtr16(img + tr256(r0 + 4, c0 + 4 * p));
    return (bf16x8){x[0], x[1], x[2], x[3], y[0], y[1], y[2], y[3]};
}
__device__ __forceinline__ void conv16(float (&v)[16], const LAS unsigned char* rawT, const LAS float* cwT, int i, int c, int p0) {
#pragma unroll
    for (int k = 0; k < 16; ++k) v[k] = 0.f;
#pragma unroll
    for (int tap = 0; tap < 4; ++tap) { const int lr = i + tap;
        if (p0 + lr >= 0) { const LAS unsigned char* xp = rawT + lr * 256 + c * 32; const u32x4 x0 = *(const LAS u32x4*)xp, x1 = *(const LAS u32x4*)(xp + 16);
            const LAS float* wp = cwT + tap * 384 + c * 16; const f32x4 w0 = *(const LAS f32x4*)wp, w1 = *(const LAS f32x4*)(wp + 4), w2 = *(const LAS f32x4*)(wp + 8), w3 = *(const LAS f32x4*)(wp + 12);
            v[0] += w0.x * bflo(x0.x); v[1] += w0.y * bfhi(x0.x); v[2] += w0.z * bflo(x0.y); v[3] += w0.w * bfhi(x0.y);
            v[4] += w1.x * bflo(x0.z); v[5] += w1.y * bfhi(x0.z); v[6] += w1.z * bflo(x0.w); v[7] += w1.w * bfhi(x0.w);
            v[8] += w2.x * bflo(x1.x); v[9] += w2.y * bfhi(x1.x); v[10] += w2.z * bflo(x1.y); v[11] += w2.w * bfhi(x1.y);
            v[12] += w3.x * bflo(x1.z); v[13] += w3.y * bfhi(x1.z); v[14] += w3.z * bflo(x1.w); v[15] += w3.w * bfhi(x1.w); } }
#pragma unroll
    for (int k = 0; k < 16; ++k) v[k] = siluf_(v[k]);
}
__device__ __forceinline__ u32x4 pack8(const float* v, float s) { u32x4 o; o.x = pk2(v[0] * s, v[1] * s); o.y = pk2(v[2] * s, v[3] * s); o.z = pk2(v[4] * s, v[5] * s); o.w = pk2(v[6] * s, v[7] * s); return o; }

constexpr int DN_RAW_T = 68 * 256, DN_RAW_HI = 90112;
constexpr int DN_CWL_OFF = SMALL_OFF + 8192;
constexpr int DN_BAR_OFF = SMALL_OFF + 5120;
static_assert(DN_CWL_OFF + 6144 <= LDS_BYTES && DN_RAW_HI + 3 * DN_RAW_T <= RING_BYTES, "dn lds map");
__device__ __forceinline__ void dn_pre_fetch(Frame& F, const Args& a, int item, LAS unsigned char* raw) {
    const int lane = F.lane, w = F.wave, n = item & 63, bh = item >> 6, b = bh >> 2, h = bh & 3;
    const char* P = (const char*)(a.ws + WS_PROJ);
    for (int j = w; j < 51; j += NWAVES) { const int T = j / 17, rg = j - 17 * T; int p = n * CH - 3 + 4 * rg + (lane >> 4); p = p < 0 ? 0 : (p > SEQ - 1 ? SEQ - 1 : p);
        const char* src = P + ((size_t)(b * SEQ + p) * PJ + T * 512 + h * 128) * 2 + (lane & 15) * 16;
        __builtin_amdgcn_global_load_lds((const unsigned*)src, (LAS unsigned*)(raw + T * DN_RAW_T + rg * 1024), 16, 0, 0); }
    if (w >= 6) { const char* src = (const char*)(a.ws + WS_BA) + ((size_t)(b * SEQ + n * CH) * 8) * 4 + (w - 6) * 1024 + lane * 16;
        __builtin_amdgcn_global_load_lds((const unsigned*)src, (LAS unsigned*)(F.lds + DN_BAR_OFF + (w - 6) * 1024), 16, 0, 0); }
}
__device__ __forceinline__ void dn_pre_cw(Frame& F, const Args& a, int h) {
    LAS float* CWL = (LAS float*)(F.lds + DN_CWL_OFF); const float* cw = a.in[3];
    for (int idx = F.tid; idx < 1536; idx += NWAVES * 64) { const int tap = idx / 384, rem = idx - tap * 384, T = rem >> 7, ch = rem & 127; CWL[idx] = cw[tap * 1536 + T * 512 + h * 128 + ch]; }
}
__device__ __forceinline__ void dn_pre_item(Frame& F, const Args& a, int item, int nitem, int par) {
    const int tid = F.tid, lane = F.lane, w = F.wave, m = lane & 15, kq = lane >> 4;
    const int n = item & 63, bh = item >> 6, h = bh & 3;
    LAS unsigned char* R = F.lds + RING_OFF;
    const int lo = par ? DN_RAW_HI : 0, hi = par ? 0 : DN_RAW_HI;
    LAS unsigned char* QN = R + 57344; LAS unsigned char* KD = R + 73728;
    LAS unsigned char* KN = R + lo; LAS unsigned char* RV = R + lo + 16384; LAS unsigned char* RK = R + lo + 32768;
    LAS float* Lm = (LAS float*)(R + hi); LAS float* Tm = (LAS float*)(R + hi + 16384);
    LAS unsigned char* WT = R + hi; LAS unsigned char* UT = R + hi + 16384;
    LAS unsigned char* QKM = R + (par ? 32768 : 122880); LAS unsigned char* TB = R + (par ? 40960 : 49152);
    const LAS unsigned char* RAW = R + hi;
    LAS float* beta = (LAS float*)(F.lds + SMALL_OFF); LAS float* gc = beta + 64; LAS float* Wt = beta + 128;
    const LAS float* BAr = (const LAS float*)(F.lds + DN_BAR_OFF); const LAS float* CWL = (const LAS float*)(F.lds + DN_CWL_OFF);
    unsigned char* dst = a.ws + WS_DN + (size_t)item * DN_ITEM;
    VM_WAIT(); __syncthreads();
    if (tid < 64) { const float bl = BAr[tid * 8 + h], al = BAr[tid * 8 + 4 + h] + a.in[5][h];
        beta[tid] = sigmoidf_(bl); float g = -__expf(a.in[4][h]) * (al > 20.f ? al : log1pf(__expf(al)));
#pragma unroll
        for (int o = 1; o < 64; o <<= 1) { const float t = __shfl_up(g, o); if (lane >= o) g += t; }
        gc[tid] = g; }
    __syncthreads();
    { const int i = tid >> 3, c = tid & 7; const float gi = gc[i], gl = gc[63], bi = beta[i]; const float ei = __expf(gi), di = __expf(gl - gi);
      float v[16];
      conv16(v, RAW, CWL, i, c, n * CH - 3);
      { float ss = 0.f;
#pragma unroll
        for (int k = 0; k < 16; ++k) ss += v[k] * v[k];
        ss += __shfl_xor(ss, 1); ss += __shfl_xor(ss, 2); ss += __shfl_xor(ss, 4);
        const float rq = rsqrtf(ss + EPS) * 0.08838834764831845f;
        *(LAS u32x4*)(QN + sw256(i, 2 * c)) = pack8(v, rq); *(LAS u32x4*)(QN + sw256(i, 2 * c + 1)) = pack8(v + 8, rq); }
      conv16(v, RAW + DN_RAW_T, CWL + 128, i, c, n * CH - 3);
      { float ss = 0.f;
#pragma unroll
        for (int k = 0; k < 16; ++k) ss += v[k] * v[k];
        ss += __shfl_xor(ss, 1); ss += __shfl_xor(ss, 2); ss += __shfl_xor(ss, 4);
        const float rk = rsqrtf(ss + EPS);
        *(LAS u32x4*)(KN + sw256(i, 2 * c)) = pack8(v, rk); *(LAS u32x4*)(KN + sw256(i, 2 * c + 1)) = pack8(v + 8, rk);
        const int tb = i * 256 + ((c ^ (i & 7)) << 5);
        *(LAS u32x4*)(RK + tb) = pack8(v, rk * bi * ei); *(LAS u32x4*)(RK + tb + 16) = pack8(v + 8, rk * bi * ei);
        *(LAS u32x4*)(KD + tb) = pack8(v, rk * di); *(LAS u32x4*)(KD + tb + 16) = pack8(v + 8, rk * di); }
      conv16(v, RAW + 2 * DN_RAW_T, CWL + 256, i, c, n * CH - 3);
      { const int tb = i * 256 + ((c ^ (i & 7)) << 5);
        *(LAS u32x4*)(RV + tb) = pack8(v, bi); *(LAS u32x4*)(RV + tb + 16) = pack8(v + 8, bi); } }
    __syncthreads();
    for (int i = tid; i < 64 * 64; i += NWAVES * 64) Tm[i] = 0.f;
    { const int mat = w >> 2, ib = w & 3; const LAS unsigned char* Aimg = mat ? QN : KN;
      bf16x8 af[4];
#pragma unroll
      for (int s = 0; s < 4; ++s) af[s] = *(const LAS bf16x8*)(Aimg + sw256(16 * ib + m, 4 * s + kq));
#pragma unroll
      for (int jb = 0; jb < 4; ++jb) { f32x4 acc = {0.f, 0.f, 0.f, 0.f};
          if (jb <= ib) {
#pragma unroll
              for (int s = 0; s < 4; ++s) { const bf16x8 bf = *(const LAS bf16x8*)(KN + sw256(16 * jb + m, 4 * s + kq)); acc = mfma16(af[s], bf, acc); } }
          const int j = 16 * jb + m; const float gj = gc[j];
#pragma unroll
          for (int r = 0; r < 4; ++r) { const int i = 16 * ib + 4 * kq + r; const float dec = (i >= j) ? __expf(gc[i] - gj) : 0.f;
              if (mat == 0) Lm[i * 64 + j] = (i > j) ? acc[r] * beta[i] * dec : 0.f;
              else *(LAS bf16_t*)(QKM + sw128(i, j >> 3) + (j & 7) * 2) = (bf16_t)f2bf(acc[r] * dec); } } }
    __syncthreads();
    {
    if (tid < 64) { const int bi = tid >> 4, c = tid & 15; float x[16];
        f32x4 rowv[4] = {{0.f, 0.f, 0.f, 0.f}, {0.f, 0.f, 0.f, 0.f}, {0.f, 0.f, 0.f, 0.f}, {0.f, 0.f, 0.f, 0.f}};
#pragma unroll
        for (int r = 0; r < 16; ++r) { f32x4 nx[4] = {{0.f, 0.f, 0.f, 0.f}, {0.f, 0.f, 0.f, 0.f}, {0.f, 0.f, 0.f, 0.f}, {0.f, 0.f, 0.f, 0.f}};
            if (r + 1 < 16) {
#pragma unroll
                for (int q = 0; q < 4; ++q) if (4 * q < r + 1) nx[q] = *(const LAS f32x4*)(Lm + (16 * bi + r + 1) * 64 + 16 * bi + 4 * q); }
            float s = (r == c) ? 1.f : 0.f;
#pragma unroll
            for (int k = 0; k < r; ++k) s -= rowv[k >> 2][k & 3] * x[k];
            x[r] = s;
#pragma unroll
            for (int q = 0; q < 4; ++q) rowv[q] = nx[q]; }
#pragma unroll
        for (int r = 0; r < 16; ++r) Tm[(16 * bi + r) * 64 + 16 * bi + c] = x[r]; }
    __syncthreads();
    { const int pr = tid >> 8, e = tid & 255, r = e >> 4, c = e & 15, bi = 2 * pr + 1, bj = 2 * pr; float s = 0.f;
#pragma unroll
      for (int k = 0; k < 16; ++k) s += Lm[(16 * bi + r) * 64 + 16 * bj + k] * Tm[(16 * bj + k) * 64 + 16 * bj + c];
      Wt[tid] = s; }
    __syncthreads();
    { const int pr = tid >> 8, e = tid & 255, r = e >> 4, c = e & 15, bi = 2 * pr + 1, bj = 2 * pr; float s = 0.f;
#pragma unroll
      for (int k = 0; k < 16; ++k) s -= Tm[(16 * bi + r) * 64 + 16 * bi + k] * Wt[pr * 256 + k * 16 + c];
      Tm[(16 * bi + r) * 64 + 16 * bj + c] = s; }
    __syncthreads();
    { float s0 = 0.f, s1 = 0.f; const int r = tid >> 5, c = tid & 31;
#pragma unroll 8
      for (int k = 0; k < 32; ++k) { const float t = Tm[k * 64 + c]; s0 += Lm[(32 + r) * 64 + k] * t; s1 += Lm[(48 + r) * 64 + k] * t; }
      __syncthreads();
      Wt[r * 32 + c] = s0; Wt[(r + 16) * 32 + c] = s1; }
    __syncthreads();
    { float s0 = 0.f, s1 = 0.f; const int r = tid >> 5, c = tid & 31;
#pragma unroll 8
      for (int k = 0; k < 32; ++k) { const float wv = Wt[k * 32 + c]; s0 -= Tm[(32 + r) * 64 + 32 + k] * wv; s1 -= Tm[(48 + r) * 64 + 32 + k] * wv; }
      Tm[(32 + r) * 64 + c] = s0; Tm[(48 + r) * 64 + c] = s1; }
    __syncthreads();
    }
    { const int i = tid >> 3, ch = tid & 7; const f32x4 t0v = *(const LAS f32x4*)(Tm + i * 64 + 8 * ch), t1v = *(const LAS f32x4*)(Tm + i * 64 + 8 * ch + 4);
      u32x4 o; o.x = pk2(t0v.x, t0v.y); o.y = pk2(t0v.z, t0v.w); o.z = pk2(t1v.x, t1v.y); o.w = pk2(t1v.z, t1v.w);
      *(LAS u32x4*)(TB + sw128(i, ch)) = o; }
    __syncthreads();
    { const LAS unsigned char* src = (w < 4) ? RV : RK; LAS unsigned char* dstT = (w < 4) ? UT : WT;
      bf16x8 tf[4][2];
#pragma unroll
      for (int ib = 0; ib < 4; ++ib)
#pragma unroll
          for (int s = 0; s < 2; ++s) tf[ib][s] = *(const LAS bf16x8*)(TB + sw128(16 * ib + m, 4 * s + kq));
      __syncthreads();
#pragma unroll
      for (int cbi = 0; cbi < 2; ++cbi) { const int cb = 2 * (w & 3) + cbi;
          const bf16x8 b0 = trfrag(src, 0, 16 * cb, lane), b1 = trfrag(src, 32, 16 * cb, lane);
#pragma unroll
          for (int ib = 0; ib < 4; ++ib) { f32x4 acc = {0.f, 0.f, 0.f, 0.f}; acc = mfma16(tf[ib][0], b0, acc); acc = mfma16(tf[ib][1], b1, acc);
              u32x2 pk; pk.x = pk2(acc[0], acc[1]); pk.y = pk2(acc[2], acc[3]);
              *(LAS u32x2*)(dstT + sw128(16 * cb + m, 2 * ib + (kq >> 1)) + (kq & 1) * 8) = pk; } } }
    __syncthreads();
    if (nitem >= 0) dn_pre_fetch(F, a, nitem, R + lo);
    {
    {
      const bf16x8 kd0 = trfrag(KD, 0, 16 * w, lane), kd1 = trfrag(KD, 32, 16 * w, lane);
      f32x4 acc[8];
#pragma unroll
      for (int nb = 0; nb < 8; ++nb) { acc[nb] = (f32x4){0.f, 0.f, 0.f, 0.f};
          const bf16x8 w0 = *(const LAS bf16x8*)(WT + sw128(16 * nb + m, kq)), w1 = *(const LAS bf16x8*)(WT + sw128(16 * nb + m, 4 + kq));
          acc[nb] = mfma16(w0, kd0, acc[nb]); acc[nb] = mfma16(w1, kd1, acc[nb]); }
      const float cd = __expf(gc[63]); const int arow = 16 * w + m;
#pragma unroll
      for (int sp = 0; sp < 4; ++sp) { float vals[8];
#pragma unroll
          for (int r = 0; r < 4; ++r) { const int b0c = 32 * sp + 4 * kq + r, b1c = b0c + 16;
              vals[r] = ((b0c == arow) ? cd : 0.f) - acc[2 * sp][r]; vals[4 + r] = ((b1c == arow) ? cd : 0.f) - acc[2 * sp + 1][r]; }
          *(u32x4*)(dst + (size_t)arow * 256 + (4 * sp + kq) * 16) = pack8(vals, 1.0f); } }
    {
      const int mi = w & 3, hf = w >> 2, irow = 16 * mi + m; const float ei = __expf(gc[irow]);
      const bf16x8 q0 = *(const LAS bf16x8*)(QKM + sw128(irow, kq)), q1 = *(const LAS bf16x8*)(QKM + sw128(irow, 4 + kq));
      f32x4 acc[4];
#pragma unroll
      for (int nbi = 0; nbi < 4; ++nbi) { const int nb = 4 * hf + nbi; acc[nbi] = (f32x4){0.f, 0.f, 0.f, 0.f};
          const bf16x8 w0 = *(const LAS bf16x8*)(WT + sw128(16 * nb + m, kq)), w1 = *(const LAS bf16x8*)(WT + sw128(16 * nb + m, 4 + kq));
          acc[nbi] = mfma16(w0, q0, acc[nbi]); acc[nbi] = mfma16(w1, q1, acc[nbi]); }
#pragma unroll
      for (int spi = 0; spi < 2; ++spi) { const int sp = 2 * hf + spi; float vals[8];
#pragma unroll
          for (int x = 0; x < 2; ++x) { const int nb = 2 * sp + x, col = 16 * nb + 4 * kq;
              const u32x2 qq = *(const LAS u32x2*)(QN + sw256(irow, col >> 3) + (col & 7) * 2);
              vals[4 * x + 0] = bflo(qq.x) * ei - acc[2 * spi + x][0]; vals[4 * x + 1] = bfhi(qq.x) * ei - acc[2 * spi + x][1];
              vals[4 * x + 2] = bflo(qq.y) * ei - acc[2 * spi + x][2]; vals[4 * x + 3] = bfhi(qq.y) * ei - acc[2 * spi + x][3]; }
          *(u32x4*)(dst + 32768 + (size_t)irow * 256 + (4 * sp + kq) * 16) = pack8(vals, 1.0f); } }
    {
      const bf16x8 u0 = *(const LAS bf16x8*)(UT + sw128(16 * w + m, kq)), u1 = *(const LAS bf16x8*)(UT + sw128(16 * w + m, 4 + kq));
      u32x2 ob[8];
#pragma unroll
      for (int ib = 0; ib < 8; ++ib) { f32x4 acc = {0.f, 0.f, 0.f, 0.f};
          acc = mfma16(trfrag(KD, 0, 16 * ib, lane), u0, acc); acc = mfma16(trfrag(KD, 32, 16 * ib, lane), u1, acc);
          ob[ib].x = pk2(acc[0], acc[1]); ob[ib].y = pk2(acc[2], acc[3]); }
      u32x4* bp = (u32x4*)(dst + 49152 + (size_t)(w * 64 + lane) * 64);
#pragma unroll
      for (int q = 0; q < 4; ++q) bp[q] = (u32x4){ob[2 * q].x, ob[2 * q].y, ob[2 * q + 1].x, ob[2 * q + 1].y};
      u32x2 oo[4];
#pragma unroll
      for (int ib = 0; ib < 4; ++ib) { f32x4 acc = {0.f, 0.f, 0.f, 0.f};
          acc = mfma16(u0, *(const LAS bf16x8*)(QKM + sw128(16 * ib + m, kq)), acc); acc = mfma16(u1, *(const LAS bf16x8*)(QKM + sw128(16 * ib + m, 4 + kq)), acc);
          oo[ib].x = pk2(acc[0], acc[1]); oo[ib].y = pk2(acc[2], acc[3]); }
      u32x4* op = (u32x4*)(dst + 81920 + (size_t)(w * 64 + lane) * 32);
      op[0] = (u32x4){oo[0].x, oo[0].y, oo[1].x, oo[1].y}; op[1] = (u32x4){oo[2].x, oo[2].y, oo[3].x, oo[3].y}; }
    }
}

template <int NSPLIT>
__device__ __forceinline__ void dn_scan(Frame& F, const Args& a, int item) {
    const int bh = item / NSPLIT, part = item % NSPLIT, NACT = 8 / NSPLIT;
    const int tid = F.tid, lane = F.lane, wv = F.wave, m = lane & 15, kq = lane >> 4, b = bh >> 2, h = bh & 3;
    const bool act = wv < NACT; const int w = part * NACT + (act ? wv : 0);
    LAS unsigned char* R = F.lds + RING_OFF;
    constexpr bool RS = (NSPLIT == 2);
#define DN_CI(n_, wv_) (R + 98304 + ((wv_) + (RS ? NACT * ((n_) & 1) : 0)) * 6144)
    bf16_t* MIX = (bf16_t*)(a.ws + WS_XN);
    const unsigned char* base = a.ws + WS_DN + (size_t)(bh * 64) * DN_ITEM;
    f32x4 S[8];
#pragma unroll
    for (int ib = 0; ib < 8; ++ib) S[ib] = (f32x4){0.f, 0.f, 0.f, 0.f};
#define DN_STAGE(n_, buf_) do { const unsigned char* ib_ = base + (size_t)(n_) * DN_ITEM; \
        _Pragma("unroll") for (int p_ = 0; p_ < 6; ++p_) { const int off_ = p_ * 8192 + tid * 16, row_ = off_ >> 8, pc_ = (off_ >> 4) & 15; \
            __builtin_amdgcn_global_load_lds((const unsigned*)(ib_ + row_ * 256 + ((pc_ ^ (row_ & 15)) << 4)), (LAS unsigned*)(R + (buf_) * 49152 + p_ * 8192 + wv * 1024), 16, 0, 0); } } while (0)
#define DN_STAGEC(n_) do { const unsigned char* ib_ = base + (size_t)(n_) * DN_ITEM; LAS unsigned char* CI = DN_CI(n_, wv); \
        _Pragma("unroll") for (int q_ = 0; q_ < 4; ++q_) __builtin_amdgcn_global_load_lds((const unsigned*)(ib_ + 49152 + (size_t)(w * 64 + lane) * 64 + q_ * 16), (LAS unsigned*)(CI + q_ * 1024), 16, 0, 0); \
        _Pragma("unroll") for (int q_ = 0; q_ < 2; ++q_) __builtin_amdgcn_global_load_lds((const unsigned*)(ib_ + 81920 + (size_t)(w * 64 + lane) * 32 + q_ * 16), (LAS unsigned*)(CI + 4096 + q_ * 1024), 16, 0, 0); } while (0)
    u32x4 rg[18];
    const int iw = wv - NACT;
#define DN_RLOAD(n_) do { const unsigned char* ib_ = base + (size_t)(n_) * DN_ITEM; \
        _Pragma("unroll") for (int k_ = 0; k_ < 12; ++k_) { const int o_ = (iw * 768 + k_ * 64 + lane) * 16, row_ = o_ >> 8, pc_ = (o_ >> 4) & 15; rg[k_] = *(const u32x4*)(ib_ + row_ * 256 + ((pc_ ^ (row_ & 15)) << 4)); } \
        const int wc_ = part * NACT + iw; \
        _Pragma("unroll") for (int q_ = 0; q_ < 4; ++q_) rg[12 + q_] = *(const u32x4*)(ib_ + 49152 + (size_t)(wc_ * 64 + lane) * 64 + q_ * 16); \
        _Pragma("unroll") for (int q_ = 0; q_ < 2; ++q_) rg[16 + q_] = *(const u32x4*)(ib_ + 81920 + (size_t)(wc_ * 64 + lane) * 32 + q_ * 16); } while (0)
#define DN_RWRITE(n_) do { LAS unsigned char* sb_ = R + ((n_) & 1) * 49152; LAS unsigned char* ci_ = DN_CI(n_, iw); \
        _Pragma("unroll") for (int k_ = 0; k_ < 12; ++k_) *(LAS u32x4*)(sb_ + (iw * 768 + k_ * 64 + lane) * 16) = rg[k_]; \
        _Pragma("unroll") for (int q_ = 0; q_ < 4; ++q_) *(LAS u32x4*)(ci_ + q_ * 1024 + lane * 16) = rg[12 + q_]; \
        _Pragma("unroll") for (int q_ = 0; q_ < 2; ++q_) *(LAS u32x4*)(ci_ + 4096 + q_ * 1024 + lane * 16) = rg[16 + q_]; } while (0)
    bf16_t* mp = MIX + (size_t)(b * SEQ + m) * D + h * 128 + 16 * w + 4 * kq;
    if (RS && !act) {
        DN_RLOAD(0); DN_RWRITE(0); DN_RLOAD(1);
#pragma unroll 1
        for (int n = 0; n < NCH; ++n) {
            __syncthreads();
            if (n + 1 < NCH) { DN_RWRITE(n + 1); }
            if (n + 2 < NCH) { DN_RLOAD(n + 2); }
        }
    } else {
    if (!RS) { DN_STAGE(0, 0); if (act) { DN_STAGEC(0); } }
#pragma unroll 1
    for (int n = 0; n < NCH; ++n) {
        asm volatile("s_waitcnt vmcnt(0)" ::: "memory");
        __syncthreads();
        if (!RS && !act) { if (n + 1 < NCH) { DN_STAGE(n + 1, (n + 1) & 1); } continue; }
        const LAS unsigned char* CI = DN_CI(n, wv);
        if (!RS && n + 1 < NCH) { DN_STAGE(n + 1, (n + 1) & 1); }
        u32x4 bn[4], oi[2];
#pragma unroll
        for (int q = 0; q < 4; ++q) bn[q] = *(const LAS u32x4*)(CI + q * 1024 + lane * 16);
        oi[0] = *(const LAS u32x4*)(CI + 4096 + lane * 16); oi[1] = *(const LAS u32x4*)(CI + 5120 + lane * 16);
        asm volatile("s_waitcnt lgkmcnt(0)" : "+v"(bn[0]), "+v"(bn[1]), "+v"(bn[2]), "+v"(bn[3]), "+v"(oi[0]), "+v"(oi[1]) :: "memory");
        if (!RS && n + 1 < NCH) { DN_STAGEC(n + 1); }
        const LAS unsigned char* buf = R + (n & 1) * 49152;
        bf16x8 sf[4];
#pragma unroll
        for (int s = 0; s < 4; ++s) { u32x4 pw; pw.x = cvtpk_s(S[2 * s][0], S[2 * s][1]); pw.y = cvtpk_s(S[2 * s][2], S[2 * s][3]);
            pw.z = cvtpk_s(S[2 * s + 1][0], S[2 * s + 1][1]); pw.w = cvtpk_s(S[2 * s + 1][2], S[2 * s + 1][3]); sf[s] = __builtin_bit_cast(bf16x8, pw); }
        const unsigned bnw[16] = {bn[0].x, bn[0].y, bn[0].z, bn[0].w, bn[1].x, bn[1].y, bn[1].z, bn[1].w, bn[2].x, bn[2].y, bn[2].z, bn[2].w, bn[3].x, bn[3].y, bn[3].z, bn[3].w};
        const unsigned oiw[8] = {oi[0].x, oi[0].y, oi[0].z, oi[0].w, oi[1].x, oi[1].y, oi[1].z, oi[1].w};
#define DN_LDBLK(FR, row0_) do { _Pragma("unroll") for (int j_ = 0; j_ < 2; ++j_) _Pragma("unroll") for (int s_ = 0; s_ < 4; ++s_) FR[j_][s_] = *(const LAS bf16x8*)(buf + sw256((row0_) + 16 * j_ + m, 4 * s_ + kq)); } while (0)
#define DN_MMAS(FR, ib0_) do { _Pragma("unroll") for (int j_ = 0; j_ < 2; ++j_) { const int ib_ = (ib0_) + j_; f32x4 acc_ = {bflo(bnw[2 * ib_]), bfhi(bnw[2 * ib_]), bflo(bnw[2 * ib_ + 1]), bfhi(bnw[2 * ib_ + 1])}; \
            _Pragma("unroll") for (int s_ = 0; s_ < 4; ++s_) acc_ = mfma16(FR[j_][s_], sf[s_], acc_); S[ib_] = acc_; } } while (0)
#define DN_MMAO(FR, ib0_) do { _Pragma("unroll") for (int j_ = 0; j_ < 2; ++j_) { const int ib_ = (ib0_) + j_; f32x4 acc_ = {bflo(oiw[2 * ib_]), bfhi(oiw[2 * ib_]), bflo(oiw[2 * ib_ + 1]), bfhi(oiw[2 * ib_ + 1])}; \
            _Pragma("unroll") for (int s_ = 0; s_ < 4; ++s_) acc_ = mfma16(sf[s_], FR[j_][s_], acc_); \
            u32x2 pk_; pk_.x = cvtpk_s(acc_[0], acc_[1]); pk_.y = cvtpk_s(acc_[2], acc_[3]); *(u32x2*)(mp + (size_t)(n * CH + 16 * ib_) * D) = pk_; } } while (0)
#define DN_SB __builtin_amdgcn_sched_barrier(0)
        bf16x8 fA[2][4], fB[2][4];
        DN_LDBLK(fA, 128);
        DN_SB; DN_LDBLK(fB, 160); DN_MMAO(fA, 0);
        DN_SB; DN_LDBLK(fA, 0);   DN_MMAO(fB, 2);
        DN_SB; DN_LDBLK(fB, 32);  DN_MMAS(fA, 0);
        DN_SB; DN_LDBLK(fA, 64);  DN_MMAS(fB, 2);
        DN_SB; DN_LDBLK(fB, 96);  DN_MMAS(fA, 4);
        DN_SB; DN_MMAS(fB, 6);
        DN_SB;
#undef DN_LDBLK
#undef DN_MMAS
#undef DN_MMAO
#undef DN_SB
    }
    }
    __syncthreads();
#undef DN_STAGE
#undef DN_STAGEC
#undef DN_RLOAD
#undef DN_RWRITE
#undef DN_CI
}
__device__ __forceinline__ void mixnorm_phase(Frame& F, const Args& a, bf16_t* MIXO) {
    const bf16_t* PROJ = (const bf16_t*)(a.ws + WS_PROJ);
    const float* dn_w = a.in[6]; const float* at_w = a.in[8]; bf16_t* MIX = (bf16_t*)(a.ws + WS_XN);
    const int lane = F.lane, gw = F.vcu * NWAVES + F.wave, NGW = F.G * NWAVES;
    u32x4 noa = {}, nzz = {}, nob = {};
    if (gw < M) { noa = *(const u32x4*)(MIX + (size_t)gw * D + 8 * lane); nzz = *(const u32x4*)(PROJ + (size_t)gw * PJ + ZA + 8 * lane); nob = *(const u32x4*)(MIX + (size_t)gw * D + 512 + 8 * lane); }
    for (int t = gw; t < M; t += NGW) {
    const u32x4 oa = noa, zz = nzz, ob = nob;
    if (t + NGW < M) { const int tn = t + NGW; noa = *(const u32x4*)(MIX + (size_t)tn * D + 8 * lane); nzz = *(const u32x4*)(PROJ + (size_t)tn * PJ + ZA + 8 * lane); nob = *(const u32x4*)(MIX + (size_t)tn * D + 512 + 8 * lane); }
    {
      const f32x4 a0 = {bflo(oa.x), bfhi(oa.x), bflo(oa.y), bfhi(oa.y)}, a1 = {bflo(oa.z), bfhi(oa.z), bflo(oa.w), bfhi(oa.w)};
      float s = (a0.x * a0.x + a0.y * a0.y) + (a0.z * a0.z + a0.w * a0.w) + (a1.x * a1.x + a1.y * a1.y) + (a1.z * a1.z + a1.w * a1.w);
#pragma unroll
      for (int o = 1; o < 16; o <<= 1) s += __shfl_xor(s, o);
      const float rs = rsqrtf(s * (1.f / 128.f) + EPS);
      const int d0 = (8 * lane) & 127; const f32x4 w0 = *(const f32x4*)(dn_w + d0), w1 = *(const f32x4*)(dn_w + d0 + 4);
      float r[8] = {a0.x * rs * w0.x, a0.y * rs * w0.y, a0.z * rs * w0.z, a0.w * rs * w0.w, a1.x * rs * w1.x, a1.y * rs * w1.y, a1.z * rs * w1.z, a1.w * rs * w1.w};
      const float z[8] = {bflo(zz.x), bfhi(zz.x), bflo(zz.y), bfhi(zz.y), bflo(zz.z), bfhi(zz.z), bflo(zz.w), bfhi(zz.w)};
#pragma unroll
      for (int i = 0; i < 8; ++i) r[i] *= siluf_(z[i]);
      u32x4 o; o.x = pk2(r[0], r[1]); o.y = pk2(r[2], r[3]); o.z = pk2(r[4], r[5]); o.w = pk2(r[6], r[7]);
      *(u32x4*)(MIXO + (size_t)t * D + 8 * lane) = o; }
    {
      const float v[8] = {bflo(ob.x), bfhi(ob.x), bflo(ob.y), bfhi(ob.y), bflo(ob.z), bfhi(ob.z), bflo(ob.w), bfhi(ob.w)};
      float s = 0.f;
#pragma unroll
      for (int i = 0; i < 8; ++i) s += v[i] * v[i];
      s = wave_sum(s);
      const float rs = rsqrtf(s * (1.f / 512.f) + EPS);
      const f32x4 w0 = *(const f32x4*)(at_w + 8 * lane), w1 = *(const f32x4*)(at_w + 8 * lane + 4);
      u32x4 o; o.x = pk2(v[0] * rs * w0.x, v[1] * rs * w0.y); o.y = pk2(v[2] * rs * w0.z, v[3] * rs * w0.w); o.z = pk2(v[4] * rs * w1.x, v[5] * rs * w1.y); o.w = pk2(v[6] * rs * w1.z, v[7] * rs * w1.w);
      *(u32x4*)(MIXO + (size_t)t * D + 512 + 8 * lane) = o; }
    }
}
enum { PH_PRO = 0, PH_INPROJ = 1, PH_DNPRE = 2, PH_MIX = 3, PH_MIXNORM = 4, PH_OUTPROJ = 5, PH_ROUTER = 6, PH_GU = 7, PH_DOWN = 8, PH_FINAL = 9, PH_END = 10 };

__global__ void __launch_bounds__(NWAVES * 64, 2) fwd_kernel(Args args) {
    extern __shared__ __attribute__((aligned(16))) unsigned char lds[];
    Frame F;
    F.lds = (LAS unsigned char*)lds;
    F.MISC = (volatile LAS unsigned*)(F.lds + MISC_OFF);
    F.tid = threadIdx.x; F.lane = F.tid & 63; F.wave = __builtin_amdgcn_readfirstlane(F.tid >> 6);
    F.G = gridDim.x; { const int bx = blockIdx.x; F.vcu = (F.G % 8 == 0) ? (bx % 8) * (F.G / 8) + bx / 8 : bx; }
    unsigned char* ws = args.ws;
    F.ctl = (gu32*)(ws + WS_CTL);
    for (int u = F.tid; u < (LDS_BYTES - LDSCTL_OFF) / 4; u += NWAVES * 64) ((LAS unsigned*)(F.lds + LDSCTL_OFF))[u] = 0u;
    __syncthreads();
    const int lo = args.ph_lo, hi = args.ph_hi;
    XcdBarrier bar; bar.bar = (unsigned*)(F.ctl + CW_BAR); bar.x = 0; bar.st = nullptr;
    if (hi - lo > 1) bar = xcd_barrier_post((unsigned*)(F.ctl + CW_BAR), F.MISC + 8);
#define IN(k) (lo <= (k) && (k) < hi)
#define SEAM(k) do { if (IN(k) && IN((k) + 1)) xcd_barrier(bar); } while (0)

    if (IN(PH_PRO)) p0_prologue(F, args);
    SEAM(PH_PRO);
    if (IN(PH_INPROJ)) {
        pg8::DenseOrder S{(const char*)(ws + WS_XN), (const char*)(ws + WS_WINT), M / 256, PJ / 256, D, F.G, (int)blockIdx.x};
        pg8::EpiProj E{(bf16_t*)(ws + WS_PROJ), PJ};
        pg8::gemm_phase<pg8::EpiProj, pg8::DenseOrder, false, true>(F.lds + RING_OFF, D, S, E, nullptr, nullptr); }
    SEAM(PH_INPROJ);
    if (IN(PH_DNPRE)) { constexpr int NIT = BATCH * DNH * NCH;
        if (F.vcu < NIT) dn_pre_fetch(F, args, F.vcu, F.lds + RING_OFF + DN_RAW_HI);
        int par = 0, hl = -1;
        for (int it = F.vcu; it < NIT; it += F.G, par ^= 1) { const int hh = (it >> 6) & 3;
            if (hh != hl) { __syncthreads(); dn_pre_cw(F, args, hh); hl = hh; }
            dn_pre_item(F, args, it, (it + F.G < NIT) ? it + F.G : -1, par); }
        __syncthreads(); }
    SEAM(PH_DNPRE);
    if (IN(PH_MIX)) {
        constexpr int NSP = 2; const int nd = F.G / 2 < 32 * NSP ? F.G / 2 : 32 * NSP;
        bf16_t* MIXB = (bf16_t*)(ws + WS_XN);
        if (F.G == 256) {
            const bool sc = (int)blockIdx.x < 64; const int j = sc ? (int)blockIdx.x : (int)blockIdx.x - 64, nr = sc ? 1 : 5;
            if (sc) { dn_scan<NSP>(F, args, blockIdx.x); __syncthreads(); }
#pragma unroll 1
            for (int r = 0; r < nr; ++r) { const int li = j + 192 * r; int item;
                if (!sc && li < 896) { const int b = li / 112, rem = li - 112 * b; item = b * 128 + (8 + (rem >> 1)) * 2 + (rem & 1); }
                else { const int sl = sc ? li : li - 896, b = sl >> 3, rem = sl & 7; item = b * 128 + ((sc ? 0 : 4) + (rem >> 1)) * 2 + (rem & 1); }
                attn_item(F, args, item, MIXB); }
        } else {
            if ((int)blockIdx.x < nd) { for (int it = blockIdx.x; it < BATCH * DNH * NSP; it += nd) dn_scan<NSP>(F, args, it); }
            else { for (int it = blockIdx.x - nd; it < BATCH * NCH * 2; it += F.G - nd) attn_item(F, args, it, MIXB); } } }
    SEAM(PH_MIX);
    if (IN(PH_MIXNORM)) mixnorm_phase(F, args, (bf16_t*)(ws + WS_XN));
    SEAM(PH_MIXNORM);
    if (IN(PH_OUTPROJ)) {
        pg8::DenseOrder S{(const char*)(ws + WS_XN), (const char*)(ws + WS_WOT), M / 256, D / 256, D, F.G, (int)blockIdx.x};
        pg8::EpiResid E{args.in[0], args.out, D};
        pg8::gemm_phase<pg8::EpiResid, pg8::DenseOrder, false, true>(F.lds + RING_OFF, D, S, E, nullptr, nullptr); }
    SEAM(PH_OUTPROJ);
    if (IN(PH_ROUTER)) {
#pragma unroll 1
        for (int st = 0; st < 2; ++st) { if (((st ^ F.vcu) & 1) == 0) p5_router_mfma(F, args); else p5_convert_experts(F, args); __syncthreads(); } }
    SEAM(PH_ROUTER);
    if (IN(PH_GU)) {
        const int nT = moe_tables(F, args);
        MoeOrder S{(const LAS int*)(F.lds + SMALL_OFF), nullptr, (const char*)(ws + WS_WGU), nT, (2 * FF) / 256, F.G, (int)blockIdx.x, (size_t)2 * FF * D * 2, 0};
        pg8::EpiSwiglu E{(bf16_t*)(ws + WS_ACT), args.in[14], args.in[16], (const float*)(ws + WS_LRS)};
        pg8::gemm_phase<pg8::EpiSwiglu, MoeOrder, true, true>(F.lds + RING_OFF, D, S, E, (const char*)(ws + WS_H2), (const int*)(ws + WS_LMETA)); }
    SEAM(PH_GU);
    if (IN(PH_DOWN)) {
        const int nT = moe_tables(F, args);
        MoeOrder S{(const LAS int*)(F.lds + SMALL_OFF), (const char*)(ws + WS_ACT), (const char*)(ws + WS_WD), nT, D / 256, F.G, (int)blockIdx.x, (size_t)D * FF * 2, 1};
        pg8::EpiDown E{(bf16_t*)args.out, (bf16_t*)(ws + WS_WGU), args.in[18], (const int*)(ws + WS_LMETA), (const float*)(ws + WS_LGATE)};
        pg8::gemm_phase<pg8::EpiDown, MoeOrder, false, true>(F.lds + RING_OFF, FF, S, E, nullptr, nullptr); }
    SEAM(PH_DOWN);
    if (IN(PH_FINAL)) p9_final(F, args);
#undef IN
#undef SEAM
}

extern "C" void kernel_launch(void* const* d_in, const int* in_sizes, int n_in, void* d_out, int out_size, void* d_ws, size_t ws_size, hipStream_t stream) {
    static int grid = 0;
    if (grid == 0) {
        if (n_in != 20 || in_sizes[0] != M * D || out_size != M * D || ws_size < WS_END) { fprintf(stderr, "kernel_launch: unexpected shapes (n_in %d, in0 %d, out %d, ws %zu < %zu)\n", n_in, n_in > 0 ? in_sizes[0] : -1, out_size, ws_size, (size_t)WS_END); grid = -1; return; }
        int dev = 0, cus = 0;
        if (hipGetDevice(&dev) != hipSuccess || hipDeviceGetAttribute(&cus, hipDeviceAttributeMultiprocessorCount, dev) != hipSuccess) { grid = -1; return; }
        if (hipFuncSetAttribute((const void*)fwd_kernel, hipFuncAttributeMaxDynamicSharedMemorySize, LDS_BYTES) != hipSuccess) { grid = -1; return; }
        (void)hipGetLastError();
        grid = cus;
        if (grid != 256) fprintf(stderr, "kernel_launch: %d CUs; this kernel is built for 256\n", grid);
    }
    if (grid < 0) return;
    unsigned char* ws = (unsigned char*)d_ws;
    (void)hipMemsetAsync(ws + WS_CTL, 0, CTL_ZERO_BYTES, stream);
    Args a{};
    for (int i = 0; i < 20; ++i) a.in[i] = (const float*)d_in[i];
    a.out = (float*)d_out; a.ws = ws;
#define LAUNCH(lo_, hi_) do { a.ph_lo = (lo_); a.ph_hi = (hi_); hipLaunchKernelGGL(fwd_kernel, dim3(grid), dim3(NWAVES * 64), LDS_BYTES, stream, a); } while (0)
    LAUNCH(PH_PRO, PH_END);
#undef LAUNCH
}
```

```cpp
#include <hip/hip_runtime.h>
#include <cstdio>
#include <cstdint>

#define LAS __attribute__((address_space(3)))
#define GAS __attribute__((address_space(1)))
typedef unsigned short bf16_t;
typedef short bf16x8 __attribute__((ext_vector_type(8)));
typedef float f32x4 __attribute__((ext_vector_type(4)));
typedef float f32x2 __attribute__((ext_vector_type(2)));
typedef unsigned u32x4 __attribute__((ext_vector_type(4)));
typedef unsigned u32x2 __attribute__((ext_vector_type(2)));
typedef GAS unsigned gu32;

constexpr int D = 1024, BATCH = 8, SEQ = 4096, M = BATCH * SEQ;
constexpr int CH = 64, NCH = SEQ / CH;
constexpr int DNH = 4, DNHD = 128;
constexpr int CAH = 8, CAD = 64, CALEFT = 8, MAXREL = 256, RELW = 2 * MAXREL + 1;
constexpr int NE = 32, TOPK = 4, FF = 1024;
constexpr int INW = 3592, PJ = 3584;
constexpr int QA = 0, KA = 512, VA = 1024, ZA = 1536, QB = 2048, KB = 2560, VB = 3072;
constexpr float EPS = 1e-6f;
constexpr int NSLOT = M * TOPK;

typedef __bf16 bf16x2h_t __attribute__((ext_vector_type(2)));
__device__ __forceinline__ unsigned pk2(float lo, float hi) { f32x2 v = {lo, hi}; bf16x2h_t b = __builtin_convertvector(v, bf16x2h_t); return __builtin_bit_cast(unsigned, b); }
__device__ __forceinline__ unsigned f2bf(float f) { return pk2(f, 0.f) & 0xffffu; }
__device__ __forceinline__ float bf2f(unsigned short b) { return __builtin_bit_cast(float, (unsigned)b << 16); }
__device__ __forceinline__ float bflo(unsigned w) { return __builtin_bit_cast(float, w << 16); }
__device__ __forceinline__ float bfhi(unsigned w) { return __builtin_bit_cast(float, w & 0xffff0000u); }
__device__ __forceinline__ float wave_sum(float v) {
#pragma unroll
    for (int o = 1; o < 64; o <<= 1) v += __shfl_xor(v, o);
    return v;
}
__device__ __forceinline__ float sigmoidf_(float x) { return __builtin_amdgcn_rcpf(1.0f + __builtin_amdgcn_exp2f(x * -1.4426950408889634f)); }
__device__ __forceinline__ float siluf_(float x) { return x * sigmoidf_(x); }
#define LDS_WAIT() asm volatile("s_waitcnt lgkmcnt(0)" ::: "memory")
#define VM_WAIT() asm volatile("s_waitcnt vmcnt(0)" ::: "memory")
namespace pg8 {
constexpr int BM = 256, BK = 64, HALF = 128, HTB = HALF * BK * 2  , STAGE_BYTES = 8 * HTB, NXCD = 8, WGM = 8;

__host__ __device__ __forceinline__ int lds_byte(int r, int c) { const int st = (r >> 4) * 2 + (c >> 5), rr = r & 15, cc = c & 31, ob = rr * 64 + cc * 2; return st * 1024 + (ob ^ (((ob >> 9) & 1) << 5)); }
__host__ __device__ __forceinline__ void stage_rc(int b, int& R, int& C) { const int st = b / 1024, sb = b % 1024, swz = sb ^ (((sb >> 9) & 1) << 5); R = (st >> 1) * 16 + swz / 64; C = (st & 1) * 32 + (swz % 64) / 2; }
__host__ __device__ __forceinline__ int perm32(int rho) { const int n = rho >> 4, i = rho & 15; return 8 * (i >> 2) + 4 * n + (i & 3); }

struct Unit { const char* a; const char* b; int pm, pn, e, row0, nvalid, lrow0; };

__device__ __forceinline__ bool static_tile(int i, int G, int c, int nM, int nN, int& pm, int& pn, int wgm = WGM) {
    const int nwg = nM * nN; const long L = (long)i * G + c; if (L >= nwg) return false;
    int wgid = (int)L; { const int q = nwg / NXCD, r = nwg % NXCD, xcd = wgid % NXCD, off = wgid / NXCD; wgid = (xcd < r ? xcd * (q + 1) : r * (q + 1) + (xcd - r) * q) + off; }
    const int nig = wgm * nN, gid = wgid / nig, fm = gid * wgm, gsz = (nM - fm) < wgm ? (nM - fm) : wgm;
    pm = fm + ((wgid % nig) % gsz); pn = (wgid % nig) / gsz; return true;
}
struct DenseOrder {
    const char* A; const char* Bt; int nM, nN, K, G, c;
    __device__ __forceinline__ bool next(int i, Unit& u) const {
        int pm, pn; if (!static_tile(i, G, c, nM, nN, pm, pn)) return false;
        u.pm = pm; u.pn = pn; u.e = 0; u.row0 = pm * BM; u.nvalid = BM; u.lrow0 = 0;
        u.a = A + (size_t)pm * BM * K * 2; u.b = Bt + (size_t)pn * BM * K * 2; return true;
    }
};

typedef __bf16 bf16x2v_t __attribute__((ext_vector_type(2)));
__device__ __forceinline__ unsigned cvt_pk_bf16(float lo, float hi) { f32x2 v = {lo, hi}; bf16x2v_t b = __builtin_convertvector(v, bf16x2v_t); return __builtin_bit_cast(unsigned, b); }


typedef int pg8_v8i __attribute__((ext_vector_type(8)));
template <class Epi, class Sched, bool GATHER, bool ALIGN_EPI, bool FP8 = false>
__device__ __forceinline__ void gemm_phase(LAS unsigned char* lds, const int K, const Sched& S, const Epi& E, const char* gbase, const int* gidx) {
    int tid_ = threadIdx.x; asm volatile("" : "+v"(tid_));
    const int tid = tid_, wid = __builtin_amdgcn_readfirstlane(tid >> 6), lane = tid & 63, wr = wid >> 2, wc = wid & 3, fr = lane & 15, fq = lane >> 4;
    const int nt = K / BK;
    unsigned voffA[2], voffB[2]; int Rr[2]; unsigned colb[2];
#pragma unroll
    for (int i = 0; i < 2; ++i) { int R, C; stage_rc(tid * 16 + i * 8192, R, C); const int Rb = Epi::PERM ? ((R & ~31) + perm32(R & 31)) : R;
        voffA[i] = (unsigned)(R * K + C) * 2u; voffB[i] = (unsigned)(Rb * K + C) * 2u; Rr[i] = R; colb[i] = (unsigned)C * 2u; }
    const size_t kstep = (size_t)(BK * 2);
    const size_t hstep = (size_t)HALF * K * 2;
    const unsigned ldsw = (unsigned)wid * 1024u;
    const int fcol = FP8 ? (32 * (fq >> 1) + 16 * (fq & 1)) : fq * 8;
    const int aoff = lds_byte(wr * 64 + fr, fcol), boff = lds_byte(wc * 32 + fr, fcol);
    unsigned cg[2][2] = {{0u, 0u}, {0u, 0u}}, ng[2][2] = {{0u, 0u}, {0u, 0u}};
#define PG8_SA(b, h) (((b) * 2 + (h)) * HTB)
#define PG8_SB(b, h) ((4 + (b) * 2 + (h)) * HTB)
#define PG8_GLDS(src, bufoff, i_) __builtin_amdgcn_global_load_lds((const unsigned*)(src), (LAS unsigned*)(lds + (bufoff) + ldsw + (i_) * 8192), 16, 0, 0)
#define PG8_STAGE_B(bufoff, gb) do { _Pragma("unroll") for (int _i = 0; _i < 2; ++_i) PG8_GLDS((const char*)(gb) + voffB[_i], bufoff, _i); } while (0)
#define PG8_STAGE_A(bufoff, pbase, kofs, half, GO) do { _Pragma("unroll") for (int _i = 0; _i < 2; ++_i) { \
        if constexpr (GATHER) PG8_GLDS(gbase + (kofs) + GO[half][_i], bufoff, _i); \
        else PG8_GLDS((pbase) + ((half) ? hstep : (size_t)0) + voffA[_i], bufoff, _i); } } while (0)
#define PG8_LDA(dst, b, h) do { if constexpr (FP8) { _Pragma("unroll") for (int m = 0; m < 4; ++m) dst##8[m] = *(const LAS pg8_v8i*)(lds + PG8_SA(b, h) + aoff + m * 2048); } \
        else { _Pragma("unroll") for (int m = 0; m < 4; ++m) _Pragma("unroll") for (int k = 0; k < 2; ++k) dst[m][k] = *(const LAS bf16x8*)(lds + PG8_SA(b, h) + aoff + m * 2048 + k * 1024); } } while (0)
#define PG8_LDB(dst, b, h) do { if constexpr (FP8) { _Pragma("unroll") for (int n = 0; n < 2; ++n) dst##8[n] = *(const LAS pg8_v8i*)(lds + PG8_SB(b, h) + boff + n * 2048); } \
        else { _Pragma("unroll") for (int n = 0; n < 2; ++n) _Pragma("unroll") for (int k = 0; k < 2; ++k) dst[n][k] = *(const LAS bf16x8*)(lds + PG8_SB(b, h) + boff + n * 2048 + k * 1024); } } while (0)
#define PG8_MMA(ai, bj, At, Bt) do { __builtin_amdgcn_s_setprio(1); _Pragma("unroll") for (int m = 0; m < 4; ++m) _Pragma("unroll") for (int n = 0; n < 2; ++n) { \
        if constexpr (FP8) asm volatile("v_mfma_scale_f32_16x16x128_f8f6f4 %0, %1, %2, %0, %3, %3 op_sel_hi:[0,0,0]" : "+v"(acc[ai][bj][m][n]) : "v"(Bt##8[n]), "v"(At##8[m]), "v"(usc));   \
        else { _Pragma("unroll") for (int k = 0; k < 2; ++k) acc[ai][bj][m][n] = __builtin_amdgcn_mfma_f32_16x16x32_bf16(Bt[n][k], At[m][k], acc[ai][bj][m][n], 0, 0, 0); } } \
        __builtin_amdgcn_s_setprio(0); } while (0)
#define PG8_WAIT_V(n) asm volatile("s_waitcnt vmcnt(" #n ")" ::: "memory")
#define PG8_WAIT_L(n) asm volatile("s_waitcnt lgkmcnt(" #n ")" ::: "memory")
#define PG8_BAR __builtin_amdgcn_s_barrier()
#define PG8_SCHED __builtin_amdgcn_sched_barrier(0)
#define PG8_LOADG(u_, G_) do { _Pragma("unroll") for (int _h = 0; _h < 2; ++_h) _Pragma("unroll") for (int _i = 0; _i < 2; ++_i) { \
        const int _t = (gidx[(u_).lrow0 + _h * HALF + Rr[_i]] >> 2) & (M - 1); G_[_h][_i] = (unsigned)_t * (unsigned)(K * 2) + colb[_i]; } } while (0)
    Unit cur, nxt; int ui = 0;
    if (!S.next(0, cur)) return;
    f32x4 acc[2][2][4][2];
#pragma unroll
    for (int a = 0; a < 2; ++a)
#pragma unroll
        for (int b = 0; b < 2; ++b)
#pragma unroll
            for (int m = 0; m < 4; ++m)
#pragma unroll
                for (int n = 0; n < 2; ++n) acc[a][b][m][n] = (f32x4){0.f, 0.f, 0.f, 0.f};
    int usc = 0x7f7f7f7f; asm volatile("" : "+v"(usc));
    bf16x8 At[4][2], B0[2][2], B1[2][2]; pg8_v8i At8[4], B08[2], B18[2];
    const char* cA = cur.a; const char* cB = cur.b;
    if constexpr (GATHER) { PG8_LOADG(cur, cg); }
    PG8_STAGE_B(PG8_SB(0, 0), cB); PG8_STAGE_B(PG8_SB(0, 1), cB + hstep); PG8_STAGE_A(PG8_SA(0, 0), cA, 0, 0, cg); PG8_STAGE_A(PG8_SA(0, 1), cA, 0, 1, cg);
    if (wr == 1) PG8_BAR;
    PG8_WAIT_V(2); PG8_BAR;
    PG8_STAGE_B(PG8_SB(1, 0), cB + kstep); PG8_STAGE_A(PG8_SA(1, 0), cA + kstep, kstep, 0, cg); PG8_STAGE_B(PG8_SB(1, 1), cB + hstep + kstep);
    PG8_WAIT_V(6); PG8_BAR;
    for (;;) {
        const bool has_next = S.next(ui + 1, nxt);
        const char* nA = has_next ? nxt.a : cA; const char* nB = has_next ? nxt.b : cB;
        LAS int* tls = (LAS int*)(lds + STAGE_BYTES + ((ui + 1) & 1) * 1024);
        LAS unsigned char* eps = lds + STAGE_BYTES + 2048 + (ui & 1) * 3072;
        if (wid == 4) E.prefetch(cur, eps, lane);
        if constexpr (GATHER) {
            if (has_next && wid == 0) { int l_ = lane; asm volatile("" : "+v"(l_)); __builtin_amdgcn_global_load_lds((const unsigned*)(gidx + nxt.lrow0 + l_ * 4), (LAS unsigned*)tls, 16, 0, 0); }
        }
        for (int t = 0; t < nt; t += 2) {
            const bool last = (t == nt - 2);
            const size_t k1 = (size_t)(t + 1) * kstep, k2 = last ? (size_t)0 : (size_t)(t + 2) * kstep, k3 = k2 + kstep;
            const char* a1 = cA + k1;
            const char* a2 = last ? nA : cA + k2; const char* b2 = last ? nB : cB + k2;
            const char* a3 = a2 + kstep; const char* b3 = b2 + kstep;
            if constexpr (GATHER) { if (t == nt - 4) {
#pragma unroll
                for (int h = 0; h < 2; ++h)
#pragma unroll
                    for (int i = 0; i < 2; ++i) { const int tk = (tls[h * HALF + Rr[i]] >> 2) & (M - 1); ng[h][i] = has_next ? (unsigned)tk * (unsigned)(K * 2) + colb[i] : cg[h][i]; } } }
            unsigned xg[2][2];
#pragma unroll
            for (int h = 0; h < 2; ++h)
#pragma unroll
                for (int i = 0; i < 2; ++i) xg[h][i] = last ? ng[h][i] : cg[h][i];
            PG8_LDB(B0, 0, 0); PG8_LDB(B1, 0, 1); PG8_SCHED; PG8_LDA(At, 0, 0); PG8_STAGE_A(PG8_SA(1, 1), a1, k1, 1, cg);
            PG8_WAIT_V(8); PG8_WAIT_L(0); PG8_BAR; PG8_MMA(0, 0, At, B0); PG8_MMA(0, 1, At, B1); PG8_BAR; PG8_SCHED;
            PG8_LDA(At, 0, 1); PG8_STAGE_B(PG8_SB(0, 0), b2); PG8_STAGE_B(PG8_SB(0, 1), b2 + hstep); PG8_STAGE_A(PG8_SA(0, 0), a2, k2, 0, xg);
            PG8_WAIT_V(8); PG8_WAIT_L(0); PG8_BAR; PG8_MMA(1, 0, At, B0); PG8_MMA(1, 1, At, B1); PG8_BAR; PG8_SCHED;
            PG8_LDB(B0, 1, 0); PG8_LDB(B1, 1, 1); PG8_SCHED; PG8_LDA(At, 1, 0); PG8_STAGE_A(PG8_SA(0, 1), a2, k2, 1, xg);
            PG8_WAIT_V(8); PG8_WAIT_L(0); PG8_BAR; PG8_MMA(0, 0, At, B0); PG8_MMA(0, 1, At, B1); PG8_BAR; PG8_SCHED;
            PG8_LDA(At, 1, 1); PG8_STAGE_B(PG8_SB(1, 0), b3); PG8_STAGE_B(PG8_SB(1, 1), b3 + hstep); PG8_STAGE_A(PG8_SA(1, 0), a3, k3, 0, xg);
            PG8_WAIT_V(8); PG8_WAIT_L(0); PG8_BAR; PG8_MMA(1, 0, At, B0); PG8_MMA(1, 1, At, B1); PG8_BAR; PG8_SCHED;
        }
        if constexpr (ALIGN_EPI) { if (wr == 0) PG8_BAR; }
        if constexpr (FP8) asm volatile("s_nop 15\n\ts_nop 15" ::: "memory");
        E(acc, cur, wr, wc, fr, fq, eps);
        if (!has_next) break;
#pragma unroll
        for (int a = 0; a < 2; ++a)
#pragma unroll
            for (int b = 0; b < 2; ++b)
#pragma unroll
                for (int m = 0; m < 4; ++m)
#pragma unroll
                    for (int n = 0; n < 2; ++n) acc[a][b][m][n] = (f32x4){0.f, 0.f, 0.f, 0.f};
        cur = nxt; cA = nA; cB = nB; ++ui;
        if constexpr (GATHER) {
#pragma unroll
            for (int h = 0; h < 2; ++h)
#pragma unroll
                for (int i = 0; i < 2; ++i) cg[h][i] = ng[h][i];
        }
        if constexpr (ALIGN_EPI) { if (wr == 1) PG8_BAR; }
    }
    PG8_WAIT_V(0);
    if constexpr (!ALIGN_EPI) { if (wr == 0) PG8_BAR; }
    PG8_BAR;
#undef PG8_SA
#undef PG8_SB
#undef PG8_GLDS
#undef PG8_STAGE_A
#undef PG8_STAGE_B
#undef PG8_LDA
#undef PG8_LDB
#undef PG8_MMA
#undef PG8_WAIT_V
#undef PG8_WAIT_L
#undef PG8_BAR
#undef PG8_SCHED
#undef PG8_LOADG
}
}
namespace pg8 {
struct EpiProj {
    static constexpr bool PERM = true;
    bf16_t* O; int ldc;
    __device__ __forceinline__ void prefetch(const Unit&, LAS unsigned char*, int) const {}
    __device__ __forceinline__ void operator()(const f32x4 (&acc)[2][2][4][2], const Unit& u, int wr, int wc, int fr, int fq, const LAS unsigned char*) const {
        const int row0 = u.row0 + wr * 64 + fr, col0 = u.pn * BM + wc * 32 + 8 * fq;
#pragma unroll
        for (int ai = 0; ai < 2; ++ai)
#pragma unroll
            for (int m = 0; m < 4; ++m) { bf16_t* rowp = O + (size_t)(row0 + ai * HALF + m * 16) * ldc + col0;
#pragma unroll
                for (int bj = 0; bj < 2; ++bj) { const f32x4 v0 = acc[ai][bj][m][0], v1 = acc[ai][bj][m][1];
                    u32x4 w; w.x = cvt_pk_bf16(v0[0], v0[1]); w.y = cvt_pk_bf16(v0[2], v0[3]); w.z = cvt_pk_bf16(v1[0], v1[1]); w.w = cvt_pk_bf16(v1[2], v1[3]);
                    *(u32x4*)(rowp + bj * HALF) = w; } }
    }
};
struct EpiResid {
    static constexpr bool PERM = false;
    const float* base; float* out; int ldc;
    __device__ __forceinline__ void prefetch(const Unit&, LAS unsigned char*, int) const {}
    __device__ __forceinline__ void operator()(const f32x4 (&acc)[2][2][4][2], const Unit& u, int wr, int wc, int fr, int fq, const LAS unsigned char*) const {
        const int row0 = u.row0 + wr * 64 + fr, col0 = u.pn * BM + wc * 32 + 4 * fq;
#define ER_OFF(e_) ((size_t)(row0 + ((e_) >> 4) * HALF + (((e_) >> 2) & 3) * 16) * ldc + col0 + (((e_) >> 1) & 1) * HALF + ((e_) & 1) * 16)
        f32x4 bs[16];
#pragma unroll
        for (int e = 0; e < 16; ++e) bs[e] = *(const f32x4*)(base + ER_OFF(e));
#pragma unroll
        for (int e = 0; e < 32; ++e) {
            *(f32x4*)(out + ER_OFF(e)) = bs[e & 15] + acc[e >> 4][(e >> 1) & 1][(e >> 2) & 3][e & 1];
            if (e + 16 < 32) bs[e & 15] = *(const f32x4*)(base + ER_OFF(e + 16)); }
#undef ER_OFF
    }
};
struct EpiSwiglu {
    static constexpr bool PERM = true;
    bf16_t* ACT; const float* bg; const float* bu;
    const float* rsc;
    float wsc;
    __device__ __forceinline__ void prefetch(const Unit& u, LAS unsigned char* ep, int lane) const {
        asm volatile("" : "+v"(lane));
        __builtin_amdgcn_global_load_lds((const unsigned*)(rsc + u.lrow0 + lane * 4), (LAS unsigned*)ep, 16, 0, 0);
        const float* bsrc = ((lane < 32) ? bg : bu) + (size_t)u.e * FF + u.pn * HALF + (lane & 31) * 4;
        __builtin_amdgcn_global_load_lds((const unsigned*)bsrc, (LAS unsigned*)(ep + 1024), 16, 0, 0);
    }
    __device__ __forceinline__ void operator()(const f32x4 (&acc)[2][2][4][2], const Unit& u, int wr, int wc, int fr, int fq, const LAS unsigned char* ep) const {
        const int fcol = u.pn * HALF + wc * 32 + 8 * fq;
        const LAS float* pg = (const LAS float*)(ep + 1024) + wc * 32 + 8 * fq; const LAS float* pu = pg + 128;
        const f32x4 g0 = *(const LAS f32x4*)pg, g1 = *(const LAS f32x4*)(pg + 4), u0 = *(const LAS f32x4*)pu, u1 = *(const LAS f32x4*)(pu + 4);
        float rsa[2][4];
#pragma unroll
        for (int ai = 0; ai < 2; ++ai)
#pragma unroll
            for (int m = 0; m < 4; ++m) rsa[ai][m] = ((const LAS float*)ep)[ai * HALF + wr * 64 + m * 16 + fr] * wsc;
#pragma unroll
        for (int ai = 0; ai < 2; ++ai)
#pragma unroll
            for (int m = 0; m < 4; ++m) { const int r = ai * HALF + wr * 64 + m * 16 + fr;
                const float rsv = rsa[ai][m];
                float o[8];
                const f32x2 rs2 = {rsv, rsv};
#pragma unroll
                for (int n = 0; n < 2; ++n)
#pragma unroll
                    for (int cp = 0; cp < 2; ++cp) { const int c0 = 2 * cp, c1 = c0 + 1;
                        const f32x2 ag = {acc[ai][0][m][n][c0], acc[ai][0][m][n][c1]}, au = {acc[ai][1][m][n][c0], acc[ai][1][m][n][c1]};
                        const f32x2 bgv = n ? (f32x2){g1[c0], g1[c1]} : (f32x2){g0[c0], g0[c1]}, buv = n ? (f32x2){u1[c0], u1[c1]} : (f32x2){u0[c0], u0[c1]};
                        f32x2 gt = ag * rs2 + bgv, up = au * rs2 + buv;
                        gt.x = fminf(gt.x, 7.0f); gt.y = fminf(gt.y, 7.0f); up.x = __builtin_amdgcn_fmed3f(up.x, -7.0f, 7.0f); up.y = __builtin_amdgcn_fmed3f(up.y, -7.0f, 7.0f);
                        const f32x2 arg = gt * (f32x2){-1.702f * 1.4426950408889634f, -1.702f * 1.4426950408889634f};
                        const f32x2 ex = {__builtin_amdgcn_exp2f(arg.x), __builtin_amdgcn_exp2f(arg.y)};
                        const f32x2 dn = ex * (f32x2){0.25f, 0.25f} + (f32x2){0.25f, 0.25f};
                        const f32x2 sg4 = {__builtin_amdgcn_rcpf(dn.x), __builtin_amdgcn_rcpf(dn.y)};
                        const f32x2 t = gt * sg4, ov = up * t + t;
                        o[n * 4 + c0] = ov.x; o[n * 4 + c1] = ov.y; }
                if (r < u.nvalid) { int lo = 0, hi = 0;
                    lo = __builtin_amdgcn_cvt_pk_fp8_f32(o[0], o[1], lo, false); lo = __builtin_amdgcn_cvt_pk_fp8_f32(o[2], o[3], lo, true);
                    hi = __builtin_amdgcn_cvt_pk_fp8_f32(o[4], o[5], hi, false); hi = __builtin_amdgcn_cvt_pk_fp8_f32(o[6], o[7], hi, true);
                    *(u32x2*)((unsigned char*)ACT + (size_t)(u.row0 + r) * FF + fcol) = (u32x2){(unsigned)lo, (unsigned)hi}; } }
    }
};
struct EpiDown {
    static constexpr bool PERM = true;
    static constexpr float WSC = 1.0f / 128.0f;
    bf16_t* Y01; bf16_t* Y23; const float* bd; const int* meta; const float* gate;
    __device__ __forceinline__ void prefetch(const Unit& u, LAS unsigned char* ep, int lane) const {
        asm volatile("" : "+v"(lane));
        __builtin_amdgcn_global_load_lds((const unsigned*)(meta + u.lrow0 + lane * 4), (LAS unsigned*)ep, 16, 0, 0);
        __builtin_amdgcn_global_load_lds((const unsigned*)(gate + u.lrow0 + lane * 4), (LAS unsigned*)(ep + 1024), 16, 0, 0);
        __builtin_amdgcn_global_load_lds((const unsigned*)(bd + (size_t)u.e * D + u.pn * BM + lane * 4), (LAS unsigned*)(ep + 2048), 16, 0, 0);
    }
    __device__ __forceinline__ void operator()(const f32x4 (&acc)[2][2][4][2], const Unit& u, int wr, int wc, int fr, int fq, const LAS unsigned char* ep) const {
        const int col0 = u.pn * BM + wc * 32 + 8 * fq;
        const long long ydelta = (const unsigned char*)Y23 - (const unsigned char*)Y01;
        f32x4 bv[2][2];
#pragma unroll
        for (int bj = 0; bj < 2; ++bj)
#pragma unroll
            for (int n = 0; n < 2; ++n) bv[bj][n] = *(const LAS f32x4*)(ep + 2048 + (wc * 32 + 8 * fq + bj * HALF + 4 * n) * 4);
#pragma unroll
        for (int ai = 0; ai < 2; ++ai) {
            int mt[4]; float gw[4];
#pragma unroll
            for (int m = 0; m < 4; ++m) { const int r = ai * HALF + wr * 64 + m * 16 + fr; const bool ok = r < u.nvalid;
                const int mv_ = ((const LAS int*)ep)[r]; const float gv_ = ((const LAS float*)(ep + 1024))[r];
                mt[m] = ok ? mv_ : -1; gw[m] = ok ? gv_ : 0.f; }
#pragma unroll
            for (int m = 0; m < 4; ++m) { const int mv = mt[m]; if (mv >= 0) { const int tok = mv >> 2, kk = mv & 3; const float g = gw[m];
                const unsigned yo = ((unsigned)tok * 2u + (unsigned)(kk & 1)) * 2048u + (unsigned)col0;
                const float g16 = g * 16.0f;
                const long long ysel = (kk & 2) ? ydelta : 0ll;
                u32x2 pc[2];
#pragma unroll
                for (int bj = 0; bj < 2; ++bj) {
                    f32x4 v0 = (acc[ai][bj][m][0] * WSC + bv[bj][0]) * g16, v1 = (acc[ai][bj][m][1] * WSC + bv[bj][1]) * g16;
#pragma unroll
                    for (int c = 0; c < 4; ++c) { v0[c] = __builtin_amdgcn_fmed3f(v0[c], -448.0f, 448.0f); v1[c] = __builtin_amdgcn_fmed3f(v1[c], -448.0f, 448.0f); }
                    int lo = 0, hi = 0;
                    lo = __builtin_amdgcn_cvt_pk_fp8_f32(v0[0], v0[1], lo, false); lo = __builtin_amdgcn_cvt_pk_fp8_f32(v0[2], v0[3], lo, true);
                    hi = __builtin_amdgcn_cvt_pk_fp8_f32(v1[0], v1[1], hi, false); hi = __builtin_amdgcn_cvt_pk_fp8_f32(v1[2], v1[3], hi, true);
                    pc[bj] = (u32x2){(unsigned)lo, (unsigned)hi}; }
                const bool od = fq & 1; const u32x2 snd = od ? pc[0] : pc[1];
                u32x2 rcv; rcv.x = (unsigned)__shfl_xor((int)snd.x, 16); rcv.y = (unsigned)__shfl_xor((int)snd.y, 16);
                const u32x4 w = od ? (u32x4){rcv.x, rcv.y, pc[1].x, pc[1].y} : (u32x4){pc[0].x, pc[0].y, rcv.x, rcv.y};
                *(u32x4*)((unsigned char*)Y01 + ysel + yo + (od ? HALF - 8 : 0)) = w; } } }
    }
};
}
constexpr size_t MiB = 1u << 20;
constexpr size_t WS_CTL = 0, CTL_ZERO_BYTES = 40 * 1024;
constexpr size_t WS_BA = 1 * MiB;
constexpr size_t WS_WINT = 6 * MiB;
constexpr size_t WS_WOT = 13 * MiB;
constexpr size_t WS_XN = 16 * MiB;
constexpr size_t WS_PROJ = 80 * MiB;
constexpr size_t WS_DNBUF = 304 * MiB;
constexpr size_t WS_LMETA = 2 * MiB;
constexpr size_t WS_LGATE = 6 * MiB;
constexpr size_t WS_LRS = 10 * MiB;
constexpr size_t WS_WGU = 16 * MiB;
constexpr size_t WS_H8 = 80 * MiB;
constexpr size_t WS_H2 = 112 * MiB;
constexpr size_t WS_ACT = 176 * MiB;
constexpr size_t WS_Y23 = 305 * MiB;
constexpr size_t WS_WD = 496 * MiB;
constexpr size_t WS_END = 530 * MiB + 512 * 1024;
static_assert(WS_LMETA + (size_t)NE * M * 4 <= WS_LGATE && WS_LGATE + (size_t)NE * M * 4 <= WS_LRS && WS_LRS + (size_t)NE * M * 4 <= WS_WGU, "ws map D");
static_assert(WS_WGU + (size_t)NE * 2 * FF * D <= WS_H8 && WS_H8 + (size_t)M * D <= WS_H2 && WS_H2 + (size_t)M * D * 2 <= WS_ACT, "ws map B");
static_assert(WS_ACT + (size_t)(NSLOT + 256) * FF <= WS_Y23 && WS_Y23 + (size_t)M * 2 * 2048 <= WS_WD && WS_WD + (size_t)NE * D * FF <= WS_END, "ws map C");
static_assert(WS_XN + (size_t)M * D * 2 <= WS_PROJ && WS_PROJ + (size_t)M * PJ * 2 <= WS_DNBUF, "ws map A");

constexpr int CW_BAR = 4096;
constexpr int CW_ECNT = 8192;

constexpr int RING_OFF = 0, RING_BYTES = 147456;
constexpr int LDSCTL_OFF = RING_BYTES, MISC_OFF = LDSCTL_OFF + 320;
constexpr int SMALL_OFF = RING_BYTES + 1024;
constexpr int LDS_BYTES = 163840;
constexpr int NWAVES = 8;

#define RLX_AGENT __ATOMIC_RELAXED, __HIP_MEMORY_SCOPE_AGENT
#define XB_TMO      128
#define XB_XCNT(j)  (256  + 64 * (j))
#define XB_XSUB(j)  (1280 + 64 * (j))
#define XB_XGEN(j)  (2304 + 64 * (j))
#define XB_TOP      3328
#define XB_TOPGEN   3392
#define XCD_BAR_WORDS 3456
#define XB_SPIN_CAP (1u << 22)

__device__ __forceinline__ unsigned xb_ld(unsigned* p)              { return __hip_atomic_load(p, __ATOMIC_RELAXED, __HIP_MEMORY_SCOPE_AGENT); }
__device__ __forceinline__ unsigned xb_add(unsigned* p, unsigned v) { return __hip_atomic_fetch_add(p, v, __ATOMIC_RELAXED, __HIP_MEMORY_SCOPE_AGENT); }
__device__ __forceinline__ unsigned xb_xcc_id() { return (unsigned)__builtin_amdgcn_s_getreg((3 << 11) | 20) & 0xFu; }
#define XB_SPIN(cond, bar) do { unsigned _sp = 0; while (cond) { __builtin_amdgcn_s_sleep(1); \
    if ((++_sp & 255u) == 0u) { if (xb_ld(&(bar)[XB_TMO])) break; if (_sp > XB_SPIN_CAP) { atomicAdd(&(bar)[XB_TMO], 1u); break; } } } } while (0)

struct XcdBarrier { unsigned* bar; unsigned x; volatile LAS unsigned* st; };

__device__ __forceinline__ XcdBarrier xcd_barrier_post(unsigned* bar, volatile LAS unsigned* st) {
    XcdBarrier b; b.bar = bar; b.x = xb_xcc_id(); b.st = st;
    if (threadIdx.x == 0) (void)xb_add(&bar[XB_XCNT(b.x)], 1u);
    return b;
}
__device__ __forceinline__ void xcd_barrier_complete(unsigned* bar, unsigned x, unsigned& nloc, unsigned& nx) {
    const unsigned G = gridDim.x * gridDim.y * gridDim.z;
    unsigned sum, cnt, mine, sp = 0u;
    for (;;) {
        sum = 0u; cnt = 0u; mine = 0u;
#pragma unroll
        for (unsigned j = 0; j < 16; ++j) { const unsigned c = xb_ld(&bar[XB_XCNT(j)]); sum += c; cnt += (c > 0u) ? 1u : 0u; mine = (j == x) ? c : mine; }
        if (sum == G) break;
        __builtin_amdgcn_s_sleep(1);
        if ((++sp & 255u) == 0u) { if (xb_ld(&bar[XB_TMO])) break; if (sp > XB_SPIN_CAP) { atomicAdd(&bar[XB_TMO], 1u); break; } }
    }
    nloc = mine > 0u ? mine : 1u; nx = cnt > 0u ? cnt : 1u;
}
__device__ __forceinline__ void xcd_barrier(const XcdBarrier& b) {
    asm volatile("s_waitcnt vmcnt(0)" ::: "memory");
    __syncthreads();
    if (threadIdx.x == 0) {
        unsigned* bar = b.bar;
        __builtin_amdgcn_s_waitcnt(0);
        unsigned nloc = b.st[0], nx = b.st[1];
        if (nloc == 0u) { xcd_barrier_complete(bar, b.x, nloc, nx); b.st[0] = nloc; b.st[1] = nx; }
        const unsigned old = xb_add(&bar[XB_XSUB(b.x)], 1u);
        const unsigned gen = old / nloc;
        if (old + 1u == (gen + 1u) * nloc) {
            __builtin_amdgcn_fence(__ATOMIC_RELEASE, "agent");
            asm volatile("s_waitcnt vmcnt(0)" ::: "memory");
            const unsigned og = xb_add(&bar[XB_TOP], 1u);
            if (og + 1u == (gen + 1u) * nx) xb_add(&bar[XB_TOPGEN], 1u);
        }
        XB_SPIN(xb_ld(&bar[XB_TOPGEN]) == gen, bar);
        __builtin_amdgcn_fence(__ATOMIC_ACQUIRE, "agent");
        asm volatile("s_waitcnt vmcnt(0)" ::: "memory");
    }
    __syncthreads();
}

struct Args { const float* in[20]; float* out; unsigned char* ws; int ph_lo, ph_hi; };
struct Frame {
    LAS unsigned char* lds; volatile LAS unsigned* MISC; gu32* ctl;
    int tid, lane, wave, vcu, G;
};
__device__ __forceinline__ void transpose_item(const float* W, int K, int N, int k0, int n_src0, bf16_t* WT, int dst_row0, float scale, LAS float* scr, int lane, const float* kscale = nullptr) {
    { f32x4 wv4[8];
#pragma unroll
      for (int i = 0; i < 8; ++i) wv4[i] = *(const f32x4*)(W + (size_t)(k0 + 8 * i + (lane >> 3)) * N + n_src0 + 4 * (lane & 7));
#pragma unroll
      for (int i = 0; i < 8; ++i) { LAS float* d = scr + (8 * i + (lane >> 3)) * 33 + 4 * (lane & 7); const float ks = kscale ? kscale[k0 + 8 * i + (lane >> 3)] : 1.0f;
          d[0] = wv4[i].x * ks; d[1] = wv4[i].y * ks; d[2] = wv4[i].z * ks; d[3] = wv4[i].w * ks; } }
    LDS_WAIT(); asm volatile("" ::: "memory");
    const int c = lane & 7;
#pragma unroll
    for (int j = 0; j < 4; ++j) { const int n = (lane >> 3) + 8 * j; const LAS float* s = scr + (8 * c) * 33 + n;
        u32x4 o; o.x = pk2(s[0 * 33] * scale, s[1 * 33] * scale); o.y = pk2(s[2 * 33] * scale, s[3 * 33] * scale); o.z = pk2(s[4 * 33] * scale, s[5 * 33] * scale); o.w = pk2(s[6 * 33] * scale, s[7 * 33] * scale);
        *(GAS u32x4*)(WT + (size_t)(dst_row0 + n) * K + k0 + 8 * c) = o; }
    LDS_WAIT(); asm volatile("" ::: "memory");
}

__device__ __forceinline__ void tr_load(f32x4 (&wv4)[8], const float* W, int N, int k0, int n_src0, int lane) {
#pragma unroll
    for (int i = 0; i < 8; ++i) wv4[i] = *(const f32x4*)(W + (size_t)(k0 + 8 * i + (lane >> 3)) * N + n_src0 + 4 * (lane & 7));
}
__device__ __forceinline__ void tr_store(const f32x4 (&wv4)[8], int K, int k0, bf16_t* WT, int dst_row0, LAS float* scr, int lane, const LAS float* kscale) {
#pragma unroll
    for (int i = 0; i < 8; ++i) { LAS float* d = scr + (8 * i + (lane >> 3)) * 33 + 4 * (lane & 7); const float ks = kscale ? kscale[k0 + 8 * i + (lane >> 3)] : 1.0f;
        d[0] = wv4[i].x * ks; d[1] = wv4[i].y * ks; d[2] = wv4[i].z * ks; d[3] = wv4[i].w * ks; }
    LDS_WAIT(); asm volatile("" ::: "memory");
    const int c = lane & 7;
#pragma unroll
    for (int j = 0; j < 4; ++j) { const int n = (lane >> 3) + 8 * j; const LAS float* s = scr + (8 * c) * 33 + n;
        u32x4 o; o.x = pk2(s[0 * 33], s[1 * 33]); o.y = pk2(s[2 * 33], s[3 * 33]); o.z = pk2(s[4 * 33], s[5 * 33]); o.w = pk2(s[6 * 33], s[7 * 33]);
        *(GAS u32x4*)(WT + (size_t)(dst_row0 + n) * K + k0 + 8 * c) = o; }
    LDS_WAIT(); asm volatile("" ::: "memory");
}

__device__ __forceinline__ void tr_store8(const f32x4 (&wv4)[8], int K, int k0, unsigned char* WT, int dst_row0, LAS float* scr, int lane, const LAS float* kscale, float sc) {
#pragma unroll
    for (int i = 0; i < 8; ++i) { LAS float* d = scr + (8 * i + (lane >> 3)) * 33 + 4 * (lane & 7); const float ks = (kscale ? kscale[k0 + 8 * i + (lane >> 3)] : 1.0f) * sc;
        d[0] = wv4[i].x * ks; d[1] = wv4[i].y * ks; d[2] = wv4[i].z * ks; d[3] = wv4[i].w * ks; }
    LDS_WAIT(); asm volatile("" ::: "memory");
    const int c = lane & 7;
#pragma unroll
    for (int j = 0; j < 4; ++j) { const int n = (lane >> 3) + 8 * j; const LAS float* s = scr + (8 * c) * 33 + n;
        int lo = 0, hi = 0;
        lo = __builtin_amdgcn_cvt_pk_fp8_f32(s[0 * 33], s[1 * 33], lo, false); lo = __builtin_amdgcn_cvt_pk_fp8_f32(s[2 * 33], s[3 * 33], lo, true);
        hi = __builtin_amdgcn_cvt_pk_fp8_f32(s[4 * 33], s[5 * 33], hi, false); hi = __builtin_amdgcn_cvt_pk_fp8_f32(s[6 * 33], s[7 * 33], hi, true);
        *(GAS u32x2*)(WT + (size_t)(dst_row0 + n) * K + k0 + 8 * c) = (u32x2){(unsigned)lo, (unsigned)hi}; }
    LDS_WAIT(); asm volatile("" ::: "memory");
}

__device__ __forceinline__ void p0_prologue(Frame& F, const Args& a) {
    LAS float* scr = (LAS float*)(F.lds + RING_OFF + F.wave * 16384);
    const int gw = F.vcu * NWAVES + F.wave, NGW = F.G * NWAVES;
    bf16_t* WinT = (bf16_t*)(a.ws + WS_WINT); bf16_t* WoT = (bf16_t*)(a.ws + WS_WOT);
    constexpr int I_IN = (D / 64) * (PJ / 32), I_O = (D / 64) * (D / 32);
    for (int it = gw; it < I_IN + I_O; it += NGW) {
        if (it < I_IN) { const int nb = it % (PJ / 32), kb = it / (PJ / 32), n0 = 32 * nb;
            transpose_item(a.in[2], D, INW, 64 * kb, n0 + (n0 >= 2048 ? 8 : 0), WinT, n0, (n0 >= QB && n0 < KB) ? 0.125f : 1.0f, scr, F.lane); }
        else { const int r = it - I_IN, nb = r % (D / 32), kb = r / (D / 32);
            transpose_item(a.in[9], D, D, 64 * kb, 32 * nb, WoT, 32 * nb, 1.0f, scr, F.lane); }
    }
    const float* x = a.in[0]; const float* nw = a.in[1]; const float* win = a.in[2];
    __syncthreads();
    LAS float* slab = (LAS float*)(F.lds + RING_OFF);
    for (int i = F.tid; i < D * 8; i += NWAVES * 64) { const int k = i >> 3, c = i & 7; slab[c * D + k] = win[(size_t)k * INW + 2048 + c]; }
    __syncthreads();
    bf16_t* XN = (bf16_t*)(a.ws + WS_XN); float* BA = (float*)(a.ws + WS_BA);
    f32x4 wv[4];
#pragma unroll
    for (int j = 0; j < 4; ++j) wv[j] = *(const f32x4*)(nw + 256 * j + 4 * F.lane);
    f32x4 vn[4];
    if (gw < M) { const f32x4* xr = (const f32x4*)(x + (size_t)gw * D) + F.lane;
#pragma unroll
        for (int j = 0; j < 4; ++j) vn[j] = xr[64 * j]; }
    for (int m = gw; m < M; m += NGW) {
        f32x4 v[4]; float s = 0.f;
#pragma unroll
        for (int j = 0; j < 4; ++j) { v[j] = vn[j]; s += (v[j].x * v[j].x + v[j].y * v[j].y) + (v[j].z * v[j].z + v[j].w * v[j].w); }
        if (m + NGW < M) { const f32x4* xr = (const f32x4*)(x + (size_t)(m + NGW) * D) + F.lane;
#pragma unroll
            for (int j = 0; j < 4; ++j) vn[j] = xr[64 * j]; }
        const float rs = 1.0f / sqrtf(wave_sum(s) * (1.f / D) + EPS);
        unsigned long long* o8 = (unsigned long long*)(XN + (size_t)m * D) + F.lane;
        float ba[8];
#pragma unroll
        for (int c = 0; c < 8; ++c) ba[c] = 0.f;
#pragma unroll
        for (int j = 0; j < 4; ++j) { v[j] = v[j] * rs * wv[j];
            o8[64 * j] = (unsigned long long)pk2(v[j].x, v[j].y) | ((unsigned long long)pk2(v[j].z, v[j].w) << 32);
#pragma unroll
            for (int c = 0; c < 8; ++c) { const f32x4 wq = *(const LAS f32x4*)(slab + c * D + 256 * j + 4 * F.lane); ba[c] += (v[j].x * wq.x + v[j].y * wq.y) + (v[j].z * wq.z + v[j].w * wq.w); } }
#pragma unroll
        for (int c = 0; c < 8; ++c) ba[c] = wave_sum(ba[c]);
        if (F.lane == 0) { *(f32x4*)(BA + (size_t)m * 8) = (f32x4){ba[0], ba[1], ba[2], ba[3]}; *(f32x4*)(BA + (size_t)m * 8 + 4) = (f32x4){ba[4], ba[5], ba[6], ba[7]}; }
    }
}

constexpr int MIX_GU_EXPERTS = 8;
__device__ __forceinline__ unsigned char* wgu8_base(const Args& a) { return (unsigned char*)a.out + (size_t)64 * MiB; }
__device__ __forceinline__ void p5_convert_experts(Frame& F, const Args& a, const int NM, const int E0) {
    LAS float* scr = (LAS float*)(F.lds + RING_OFF + F.wave * 16384);
    const int gw = F.vcu * NWAVES + F.wave, NGW = F.G * NWAVES;
    unsigned char* WGU8 = wgu8_base(a); unsigned char* WD8 = a.ws + WS_WD;
    constexpr int I_E = (D / 64) * (FF / 32); const int NI = (NE - E0) * NM * I_E;
#define CV_ITEM(it_) const int ee_ = (it_) / (NM * I_E), e_ = E0 + ee_, r_ = (it_) - ee_ * (NM * I_E), wh_ = r_ / I_E, q_ = r_ % I_E, n0_ = 32 * (q_ % 32), k0_ = 64 * (q_ / 32); \
        const float* src_ = (wh_ == 0 ? a.in[13] : wh_ == 1 ? a.in[15] : a.in[17]) + (size_t)e_ * D * FF
#define CV_LOAD(buf_, it_) do { CV_ITEM(it_); tr_load(buf_, src_, 1024, k0_, n0_, F.lane); } while (0)
#define CV_STORE(buf_, it_) do { CV_ITEM(it_); (void)src_; \
        if (wh_ == 2) tr_store8(buf_, 1024, k0_, WD8 + (size_t)e_ * D * FF, n0_, scr, F.lane, nullptr, 32.0f); \
        else tr_store8(buf_, 1024, k0_, WGU8 + (size_t)e_ * 2 * FF * D, 256 * (n0_ / 128) + (wh_ ? 128 : 0) + (n0_ % 128), scr, F.lane, nwl, 32.0f); } while (0)
    LAS float* nwl = (LAS float*)(F.lds + RING_OFF + 131072);
    __syncthreads();
    for (int i = F.tid; i < D; i += NWAVES * 64) nwl[i] = a.in[10][i];
    __syncthreads();
    f32x4 b0[8], b1[8];
    int it = gw;
    if (it < NI) CV_LOAD(b0, it);
    for (; it < NI; it += 2 * NGW) {
        if (it + NGW < NI) CV_LOAD(b1, it + NGW);
        CV_STORE(b0, it);
        if (it + NGW < NI) { if (it + 2 * NGW < NI) CV_LOAD(b0, it + 2 * NGW);
            CV_STORE(b1, it + NGW); }
    }
#undef CV_ITEM
#undef CV_LOAD
#undef CV_STORE
}

__device__ __forceinline__ void p5_convert_wd_wave(Frame& F, const Args& a, int widx, int nw) {
    LAS float* scr = (LAS float*)(F.lds + RING_OFF + F.wave * 16384);
    unsigned char* WD8 = a.ws + WS_WD;
    constexpr int I_E = (D / 64) * (FF / 32), NI = NE * I_E;
#define WDV_LOAD(buf_, it_) do { const int e_ = (it_) / I_E, q_ = (it_) % I_E; tr_load(buf_, a.in[17] + (size_t)e_ * D * FF, 1024, 64 * (q_ / 32), 32 * (q_ % 32), F.lane); } while (0)
#define WDV_STORE(buf_, it_) do { const int e_ = (it_) / I_E, q_ = (it_) % I_E; tr_store8(buf_, 1024, 64 * (q_ / 32), WD8 + (size_t)e_ * D * FF, 32 * (q_ % 32), scr, F.lane, nullptr, 32.0f); } while (0)
    f32x4 b0[8], b1[8];
    int it = widx;
    if (it < NI) WDV_LOAD(b0, it);
    for (; it < NI; it += 2 * nw) {
        if (it + nw < NI) WDV_LOAD(b1, it + nw);
        WDV_STORE(b0, it);
        if (it + nw < NI) { if (it + 2 * nw < NI) WDV_LOAD(b0, it + 2 * nw);
            WDV_STORE(b1, it + nw); }
    }
#undef WDV_LOAD
#undef WDV_STORE
}
__device__ __forceinline__ void p5_convert_gu_wave(Frame& F, const Args& a, int widx, int nw, int E1) {
    LAS float* scr = (LAS float*)(F.lds + RING_OFF + F.wave * 16384); LAS float* nwl = scr + 2176;
    unsigned char* WGU8 = wgu8_base(a);
    constexpr int I_E = (D / 64) * (FF / 32); const int NI = E1 * 2 * I_E;
    for (int i = F.lane; i < D; i += 64) nwl[i] = a.in[10][i];
    LDS_WAIT();
#define GUV_ITEM(it_) const int e_ = (it_) / (2 * I_E), r_ = (it_) - e_ * (2 * I_E), wh_ = r_ / I_E, q_ = r_ % I_E, n0_ = 32 * (q_ % 32), k0_ = 64 * (q_ / 32)
#define GUV_LOAD(buf_, it_) do { GUV_ITEM(it_); tr_load(buf_, (wh_ ? a.in[15] : a.in[13]) + (size_t)e_ * D * FF, 1024, k0_, n0_, F.lane); } while (0)
#define GUV_STORE(buf_, it_) do { GUV_ITEM(it_); tr_store8(buf_, 1024, k0_, WGU8 + (size_t)e_ * 2 * FF * D, 256 * (n0_ / 128) + (wh_ ? 128 : 0) + (n0_ % 128), scr, F.lane, nwl, 32.0f); } while (0)
    f32x4 b0[8], b1[8];
    int it = widx;
    if (it < NI) GUV_LOAD(b0, it);
    for (; it < NI; it += 2 * nw) {
        if (it + nw < NI) GUV_LOAD(b1, it + nw);
        GUV_STORE(b0, it);
        if (it + nw < NI) { if (it + 2 * nw < NI) GUV_LOAD(b0, it + 2 * nw);
            GUV_STORE(b1, it + nw); }
    }
#undef GUV_ITEM
#undef GUV_LOAD
#undef GUV_STORE
}

__device__ __forceinline__ void p5_router(Frame& F, const Args& a) {
    LAS float* Wt = (LAS float*)(F.lds + RING_OFF);
    LAS int* hist = (LAS int*)(F.lds + SMALL_OFF);
    LAS int* gbase = hist + 32; LAS int* asg = hist + 64; LAS float* asgg = (LAS float*)(hist + 64 + 512);
    const float* wr = a.in[11]; const float* br = a.in[12]; const float* nw = a.in[10];
    for (int i = F.tid; i < D * NE; i += NWAVES * 64) { const int k = i >> 5, e = i & 31; Wt[e * D + k] = wr[i]; }
    if (F.tid < NE) hist[F.tid] = 0;
    __syncthreads();
    const float* x2 = a.out; bf16_t* H2 = (bf16_t*)(a.ws + WS_H2);
    f32x4 wv[4];
#pragma unroll
    for (int j = 0; j < 4; ++j) wv[j] = *(const f32x4*)(nw + 256 * j + 4 * F.lane);
    const float myb = br[F.lane & 31];
    const int wg = blockIdx.x;
    f32x4 vn[4];
    { const f32x4* xr0 = (const f32x4*)(x2 + (size_t)(wg * 128 + F.wave * 16) * D) + F.lane;
#pragma unroll
      for (int j = 0; j < 4; ++j) vn[j] = (F.G * 128 == M) ? xr0[64 * j] : (f32x4){0.f, 0.f, 0.f, 0.f}; }
    if (F.G * 128 == M)
    for (int r = 0; r < 16; ++r) {
        const int m = wg * 128 + F.wave * 16 + r;
        f32x4 v[4]; float s = 0.f;
#pragma unroll
        for (int j = 0; j < 4; ++j) { v[j] = vn[j]; s += (v[j].x * v[j].x + v[j].y * v[j].y) + (v[j].z * v[j].z + v[j].w * v[j].w); }
        if (r + 1 < 16) { const f32x4* xr = (const f32x4*)(x2 + (size_t)(m + 1) * D) + F.lane;
#pragma unroll
            for (int j = 0; j < 4; ++j) vn[j] = xr[64 * j]; }
        const float rs = 1.0f / sqrtf(wave_sum(s) * (1.f / D) + EPS);
        unsigned long long* o8 = (unsigned long long*)(H2 + (size_t)m * D) + F.lane;
#pragma unroll
        for (int j = 0; j < 4; ++j) { v[j] = v[j] * rs * wv[j]; o8[64 * j] = (unsigned long long)pk2(v[j].x, v[j].y) | ((unsigned long long)pk2(v[j].z, v[j].w) << 32); }
        float lg[32];
#pragma unroll
        for (int e = 0; e < 32; ++e) { float acc = 0.f;
#pragma unroll
            for (int j = 0; j < 4; ++j) { const f32x4 w = *(const LAS f32x4*)(Wt + e * D + 256 * j + 4 * F.lane); acc += (v[j].x * w.x + v[j].y * w.y) + (v[j].z * w.z + v[j].w * w.w); }
            lg[e] = acc; if ((e & 3) == 3) __builtin_amdgcn_sched_barrier(0); }
#define RS_STAGE(W, BIT) { const bool up_ = (F.lane >> (BIT)) & 1; _Pragma("unroll") for (int i_ = 0; i_ < (W); ++i_) { const float keep_ = up_ ? lg[i_ + (W)] : lg[i_]; const float give_ = up_ ? lg[i_] : lg[i_ + (W)]; lg[i_] = keep_ + __shfl_xor(give_, 1 << (BIT)); } }
        RS_STAGE(16, 4) RS_STAGE(8, 3) RS_STAGE(4, 2) RS_STAGE(2, 1) RS_STAGE(1, 0)
#undef RS_STAGE
        float logit = lg[0] + __shfl_xor(lg[0], 32) + myb;
        int sel_e[4]; float sel_v[4];
        { const int me = F.lane & 31, li = __float_as_int(logit); int rank = 0;
#pragma unroll
          for (int e = 0; e < 32; ++e) { const float le = __int_as_float(__builtin_amdgcn_readlane(li, e)); rank += (le > logit || (le == logit && e < me)) ? 1 : 0; }
#pragma unroll
          for (int k = 0; k < 4; ++k) { const unsigned long long mk = __ballot(rank == k); const int ek = __builtin_ctzll(mk | (1ull << 63)) & 31;
              sel_e[k] = ek; sel_v[k] = __int_as_float(__builtin_amdgcn_readlane(li, ek)); } }
        const float e0 = 1.0f, e1 = __expf(sel_v[1] - sel_v[0]), e2 = __expf(sel_v[2] - sel_v[0]), e3 = __expf(sel_v[3] - sel_v[0]);
        const float inv = 1.0f / (e0 + e1 + e2 + e3);
        if (F.lane == 0) { const int tl = F.wave * 16 + r; const float gg[4] = {e0 * inv, e1 * inv, e2 * inv, e3 * inv};
#pragma unroll
            for (int k = 0; k < 4; ++k) { const int rk = __hip_atomic_fetch_add(&hist[sel_e[k]], 1, __ATOMIC_RELAXED, __HIP_MEMORY_SCOPE_WORKGROUP); asg[tl * 4 + k] = (sel_e[k] << 16) | rk; asgg[tl * 4 + k] = gg[k]; } }
    }
    __syncthreads();
    if (F.tid < NE) gbase[F.tid] = (int)__hip_atomic_fetch_add((unsigned*)(F.ctl + CW_ECNT + F.tid), (unsigned)hist[F.tid], __ATOMIC_RELAXED, __HIP_MEMORY_SCOPE_AGENT);
    __syncthreads();
    if (F.G * 128 == M) { const int av = asg[F.tid], e = av >> 16, pos = gbase[e] + (av & 0xffff);
        ((int*)(a.ws + WS_LMETA))[e * M + pos] = (wg * 128 + (F.tid >> 2)) * 4 + (F.tid & 3); ((float*)(a.ws + WS_LGATE))[e * M + pos] = asgg[F.tid]; }
    __syncthreads();
}

constexpr size_t WS_RS = WS_BA;
__device__ __forceinline__ void p5_router_mfma(Frame& F, const Args& a) {
    LAS float* Wt = (LAS float*)(F.lds + RING_OFF);
    LAS float* lgs = (LAS float*)(F.lds + RING_OFF + 131072 + F.wave * 2048);
    LAS int* hist = (LAS int*)(F.lds + SMALL_OFF);
    LAS int* gbase = hist + 32; LAS int* asg = hist + 64; LAS float* asgg = (LAS float*)(hist + 64 + 512); LAS float* rsl = (LAS float*)(hist + 64 + 1024);
    const float* wr = a.in[11]; const float* br = a.in[12]; const float* nw = a.in[10];
    for (int i = F.tid; i < D * NE; i += NWAVES * 64) Wt[i] = wr[i] * nw[i >> 5];
    if (F.tid < NE) hist[F.tid] = 0;
    __syncthreads();
    const float* x2 = a.in[0]; const bf16_t* ob = (const bf16_t*)a.out; bf16_t* H2 = (bf16_t*)(a.ws + WS_H2); float* RS = (float*)(a.ws + WS_RS);
    const int wg = blockIdx.x, lane = F.lane, ti = lane & 15, kk = lane >> 4;
    if (F.G * 128 == M) {
        const int t0 = wg * 128 + F.wave * 16;
        const float* xrow = x2 + (size_t)(t0 + ti) * D + 4 * kk; bf16_t* hrow = H2 + (size_t)(t0 + ti) * D + 4 * kk; const bf16_t* orow = ob + (size_t)(t0 + ti) * D + 4 * kk;
        unsigned char* h8row = a.ws + WS_H8 + (size_t)(t0 + ti) * D + 4 * kk;
        const LAS float* wl = Wt + (4 * kk) * 32 + ti;
        f32x4 acc0 = {0.f, 0.f, 0.f, 0.f}, acc1 = {0.f, 0.f, 0.f, 0.f}; float ssq = 0.f;
#define RT_LOAD(buf_, c0_) do { _Pragma("unroll") for (int q_ = 0; q_ < 8; ++q_) { buf_[q_] = *(const f32x4*)(xrow + 16 * ((c0_) + q_)); buf_##o[q_] = *(const u32x2*)(orow + 16 * ((c0_) + q_)); } } while (0)
#define RT_PROC(buf_, c0_) do { _Pragma("unroll") for (int q_ = 0; q_ < 8; ++q_) { const u32x2 ov_ = buf_##o[q_]; const f32x4 xv = buf_[q_] + (f32x4){bflo(ov_.x), bfhi(ov_.x), bflo(ov_.y), bfhi(ov_.y)}; const int c = (c0_) + q_; \
            ssq += (xv.x * xv.x + xv.y * xv.y) + (xv.z * xv.z + xv.w * xv.w); \
            u32x2 hp; hp.x = pk2(xv.x, xv.y); hp.y = pk2(xv.z, xv.w); *(u32x2*)(hrow + 16 * c) = hp; \
            { int h8_ = 0; h8_ = __builtin_amdgcn_cvt_pk_fp8_f32(__builtin_amdgcn_fmed3f(xv.x, -448.0f, 448.0f), __builtin_amdgcn_fmed3f(xv.y, -448.0f, 448.0f), h8_, false); \
              h8_ = __builtin_amdgcn_cvt_pk_fp8_f32(__builtin_amdgcn_fmed3f(xv.z, -448.0f, 448.0f), __builtin_amdgcn_fmed3f(xv.w, -448.0f, 448.0f), h8_, true); *(int*)(h8row + 16 * c) = h8_; } \
            _Pragma("unroll") for (int s = 0; s < 4; ++s) { const float b0 = wl[(16 * c + s) * 32], b1 = wl[(16 * c + s) * 32 + 16]; \
                acc0 = __builtin_amdgcn_mfma_f32_16x16x4f32(xv[s], b0, acc0, 0, 0, 0); acc1 = __builtin_amdgcn_mfma_f32_16x16x4f32(xv[s], b1, acc1, 0, 0, 0); } } } while (0)
        f32x4 xa[8], xb[8]; u32x2 xao[8], xbo[8];
        RT_LOAD(xa, 0);
#pragma unroll 1
        for (int cb = 0; cb < 64; cb += 16) {
            RT_LOAD(xb, cb + 8);
            RT_PROC(xa, cb);
            if (cb + 16 < 64) RT_LOAD(xa, cb + 16);
            RT_PROC(xb, cb + 8);
        }
#undef RT_LOAD
#undef RT_PROC
        ssq += __shfl_xor(ssq, 16); ssq += __shfl_xor(ssq, 32);
        const float rs = 1.0f / sqrtf(ssq * (1.f / D) + EPS);
        if (kk == 0) { RS[t0 + ti] = rs; rsl[F.wave * 16 + ti] = rs; }
        LDS_WAIT();
        { const f32x4 rv = *(const LAS f32x4*)(rsl + F.wave * 16 + 4 * kk); const float bb0 = br[ti], bb1 = br[16 + ti];
#pragma unroll
          for (int r = 0; r < 4; ++r) { lgs[ti * 16 + 4 * kk + r] = acc0[r] * rv[r] + bb0; lgs[(16 + ti) * 16 + 4 * kk + r] = acc1[r] * rv[r] + bb1; } }
        LDS_WAIT();
        if (lane < 16) { float v[32];
#pragma unroll
            for (int e = 0; e < 32; ++e) v[e] = lgs[e * 16 + lane];
            int sel_e[4]; float sel_v[4];
#pragma unroll
            for (int k = 0; k < 4; ++k) { float bv = v[0]; int be = 0;
#pragma unroll
                for (int e = 1; e < 32; ++e) { const bool gt = v[e] > bv; bv = gt ? v[e] : bv; be = gt ? e : be; }
                sel_e[k] = be; sel_v[k] = bv;
#pragma unroll
                for (int e = 0; e < 32; ++e) v[e] = (e == be) ? -INFINITY : v[e]; }
            const float e0 = 1.0f, e1 = __expf(sel_v[1] - sel_v[0]), e2 = __expf(sel_v[2] - sel_v[0]), e3 = __expf(sel_v[3] - sel_v[0]);
            const float inv = 1.0f / (e0 + e1 + e2 + e3); const float gg[4] = {e0 * inv, e1 * inv, e2 * inv, e3 * inv};
            const int tl = F.wave * 16 + lane;
#pragma unroll
            for (int k = 0; k < 4; ++k) { const int rk = __hip_atomic_fetch_add(&hist[sel_e[k]], 1, __ATOMIC_RELAXED, __HIP_MEMORY_SCOPE_WORKGROUP); asg[tl * 4 + k] = (sel_e[k] << 16) | rk; asgg[tl * 4 + k] = gg[k]; } }
    }
    __syncthreads();
    if (F.tid < NE) gbase[F.tid] = (int)__hip_atomic_fetch_add((unsigned*)(F.ctl + CW_ECNT + F.tid), (unsigned)hist[F.tid], __ATOMIC_RELAXED, __HIP_MEMORY_SCOPE_AGENT);
    __syncthreads();
    if (F.G * 128 == M) { const int av = asg[F.tid], e = av >> 16, pos = gbase[e] + (av & 0xffff);
        ((int*)(a.ws + WS_LMETA))[e * M + pos] = (wg * 128 + (F.tid >> 2)) * 4 + (F.tid & 3); ((float*)(a.ws + WS_LGATE))[e * M + pos] = asgg[F.tid]; ((float*)(a.ws + WS_LRS))[e * M + pos] = rsl[F.tid >> 2]; }
    __syncthreads();
}

#ifndef MOE_WGM_GU
#define MOE_WGM_GU 8
#endif
struct MoeOrder {
    const LAS int* tab; const char* Abase; const char* Bbase; int nT, nN, G, c; size_t bexp; int rev;
    size_t bnt;
    size_t apitch;
    __device__ __forceinline__ bool next(int i, pg8::Unit& u) const {
        int pm, pn; if (!pg8::static_tile(i, G, c, nT, nN, pm, pn, nN == 8 ? MOE_WGM_GU : 8)) return false;
        if (rev) pm = nT - 1 - pm;
        const int e = __builtin_amdgcn_readfirstlane(tab[100 + pm]);
        const int j = pm - tab[e], cnt = tab[66 + e], rs = tab[33 + e];
        u.pm = pm; u.pn = pn; u.e = e; u.row0 = rs + 256 * j; u.nvalid = (cnt - 256 * j) < 256 ? (cnt - 256 * j) : 256; u.lrow0 = e * M + 256 * j;
        u.a = Abase + (size_t)u.row0 * apitch; u.b = Bbase + (size_t)e * bexp + (size_t)pn * bnt; return true;
    }
};
__device__ __forceinline__ int moe_tables(Frame& F, const Args& a) {
    LAS int* tab = (LAS int*)(F.lds + SMALL_OFF);
    if (F.tid < 64) { const gu32* CNT = F.ctl + CW_ECNT; const int e = F.tid & 31;
        const int c = (int)__hip_atomic_load(CNT + e, __ATOMIC_RELAXED, __HIP_MEMORY_SCOPE_AGENT);
        int t = (c + 255) >> 8, r = c;
#pragma unroll
        for (int o = 1; o < 32; o <<= 1) { const int tu = __shfl_up(t, o), ru = __shfl_up(r, o); if (e >= o) { t += tu; r += ru; } }
        if (F.tid < 32) { tab[e] = t - ((c + 255) >> 8); tab[33 + e] = r - c; tab[66 + e] = c; if (e == 31) { tab[32] = t; tab[65] = r; } } }
    __syncthreads();
    const int nT = tab[32];
    for (int mt = F.tid; mt < nT; mt += NWAVES * 64) { int e = 0;
#pragma unroll 1
        for (int q = 1; q < NE; ++q) if (tab[q] <= mt) e = q;
        tab[100 + mt] = e; }
    __syncthreads();
    return nT;
}

__device__ __forceinline__ void p9_final(Frame& F, const Args& a) {
    const int gw = F.vcu * NWAVES + F.wave, NGW = F.G * NWAVES;
    const bf16_t* H2 = (const bf16_t*)(a.ws + WS_H2); const bf16_t* Y01 = (const bf16_t*)a.out; const float* fw = a.in[19];
    f32x4 wv[4];
#pragma unroll
    for (int j = 0; j < 4; ++j) wv[j] = *(const f32x4*)(fw + 256 * j + 4 * F.lane);
    const unsigned char* Y01b = (const unsigned char*)a.out; const unsigned char* Y23b = (const unsigned char*)(a.ws + WS_Y23);
#define P9_LOAD(m_, H_, A_, B_, C_, D_) do { _Pragma("unroll") for (int j = 0; j < 4; ++j) { H_[j] = *((const u32x2*)(H2 + (size_t)(m_) * D) + 64 * j + F.lane); \
            A_[j] = *((const int*)(Y01b + (size_t)(m_) * 4096) + 64 * j + F.lane); B_[j] = *((const int*)(Y01b + (size_t)(m_) * 4096 + 2048) + 64 * j + F.lane); \
            C_[j] = *((const int*)(Y23b + (size_t)(m_) * 4096) + 64 * j + F.lane); D_[j] = *((const int*)(Y23b + (size_t)(m_) * 4096 + 2048) + 64 * j + F.lane); } } while (0)
    u32x2 nh[4]; int n0[4], n1[4], n2[4], n3[4];
    if (gw < M) P9_LOAD(gw, nh, n0, n1, n2, n3);
    for (int m = gw; m < M; m += NGW) {
        u32x2 hv[4]; int y0[4], y1[4], y2[4], y3[4];
#pragma unroll
        for (int j = 0; j < 4; ++j) { hv[j] = nh[j]; y0[j] = n0[j]; y1[j] = n1[j]; y2[j] = n2[j]; y3[j] = n3[j]; }
        if (m + NGW < M) P9_LOAD(m + NGW, nh, n0, n1, n2, n3);
        f32x4 v[4]; float s = 0.f;
#pragma unroll
        for (int j = 0; j < 4; ++j) {
            const f32x2 a0 = __builtin_amdgcn_cvt_pk_f32_fp8(y0[j], false), a1 = __builtin_amdgcn_cvt_pk_f32_fp8(y0[j], true), b0 = __builtin_amdgcn_cvt_pk_f32_fp8(y1[j], false), b1 = __builtin_amdgcn_cvt_pk_f32_fp8(y1[j], true);
            const f32x2 c0 = __builtin_amdgcn_cvt_pk_f32_fp8(y2[j], false), c1 = __builtin_amdgcn_cvt_pk_f32_fp8(y2[j], true), d0 = __builtin_amdgcn_cvt_pk_f32_fp8(y3[j], false), d1 = __builtin_amdgcn_cvt_pk_f32_fp8(y3[j], true);
            const f32x2 lo = (a0 + b0) + (c0 + d0), hi = (a1 + b1) + (c1 + d1);
            v[j].x = bflo(hv[j].x) + lo.x * 0.0625f; v[j].y = bfhi(hv[j].x) + lo.y * 0.0625f; v[j].z = bflo(hv[j].y) + hi.x * 0.0625f; v[j].w = bfhi(hv[j].y) + hi.y * 0.0625f;
            s += (v[j].x * v[j].x + v[j].y * v[j].y) + (v[j].z * v[j].z + v[j].w * v[j].w); }
        const float rs = 1.0f / sqrtf(wave_sum(s) * (1.f / D) + EPS);
        f32x4* xo = (f32x4*)(a.out + (size_t)m * D) + F.lane;
#pragma unroll
        for (int j = 0; j < 4; ++j) xo[64 * j] = v[j] * rs * wv[j];
    }
#undef P9_LOAD
}
typedef float f32x16 __attribute__((ext_vector_type(16)));
typedef short s16x4 __attribute__((ext_vector_type(4)));
typedef __bf16 bf16x2_t __attribute__((ext_vector_type(2)));
__device__ __forceinline__ unsigned cvtpk_s(float lo, float hi) { f32x2 v = {lo, hi}; bf16x2_t b = __builtin_convertvector(v, bf16x2_t); return __builtin_bit_cast(unsigned, b); }
constexpr int ATT_BT = 320;
constexpr int ATT_SM_PER_WAVE = ATT_BT * 4 + 128;
__device__ __forceinline__ s16x4 vtr16(const LAS void* p) { return __builtin_bit_cast(s16x4, __builtin_amdgcn_ds_read_tr16_b64_v4i16((LAS s16x4*)p)); }

__device__ __forceinline__ void attn_item(Frame& F, const Args& a, int item, bf16_t* MIX, int& hl) {
    const bf16_t* PROJ = (const bf16_t*)(a.ws + WS_PROJ);
    const int lane = F.lane, w = F.wave, hg = item & 1, n = (item >> 1) & 63, b = item >> 7;
    const int h = 4 * hg + (w >> 1), qb = w & 1, r32 = lane & 31, hh = lane >> 5;
    LAS unsigned char* Kb = F.lds + RING_OFF + w * 16384;
    LAS unsigned char* Vb = Kb + 8192;
    LAS float* bt = (LAS float*)(F.lds + SMALL_OFF + w * ATT_SM_PER_WAVE);
    LAS float* bc = bt + ATT_BT;
    constexpr float L2E = 1.4426950408889634f;
    if (h != hl) { for (int i = lane; i < ATT_BT; i += 64) bt[i] = a.in[7][h * RELW + 193 + i]; hl = h; }
    const int t0 = b * SEQ + n * CH;
    bf16x8 qf[4];
    { const bf16_t* qp = PROJ + (size_t)(t0 + 32 * qb + r32) * PJ + QB + h * 64 + 8 * hh;
#pragma unroll
      for (int s = 0; s < 4; ++s) qf[s] = *(const bf16x8*)(qp + 16 * s); }
    f32x16 o0 = {}, o1 = {};
    float mrun = -INFINITY, lrun = 0.f;
    const int jt0 = (CALEFT - n) > 0 ? (CALEFT - n) : 0;
    const unsigned ksrc = ((unsigned)(lane >> 3) * PJ + KB + h * 64 + 8 * ((lane & 7) ^ ((lane >> 3) & 7))) * 2u, vsrc = ((unsigned)(lane >> 3) * PJ + VB + h * 64 + 8 * (lane & 7)) * 2u;
#define ATT_TP(jt_) ((const unsigned char*)(PROJ + (size_t)(b * SEQ + (n - CALEFT + (jt_)) * CH) * PJ))
#define ATT_LOADK(jt_) do { const unsigned char* tp_ = ATT_TP(jt_); _Pragma("unroll") for (int i_ = 0; i_ < 8; ++i_) \
        __builtin_amdgcn_global_load_lds((const unsigned*)(tp_ + (size_t)(8 * i_) * PJ * 2 + ksrc), (LAS unsigned*)(Kb + i_ * 1024), 16, 0, 0); } while (0)
#define ATT_LOADV(jt_) do { const unsigned char* tp_ = ATT_TP(jt_); _Pragma("unroll") for (int i_ = 0; i_ < 8; ++i_) \
        __builtin_amdgcn_global_load_lds((const unsigned*)(tp_ + (size_t)(8 * i_) * PJ * 2 + vsrc), (LAS unsigned*)(Vb + i_ * 1024), 16, 0, 0); } while (0)
    asm volatile("s_waitcnt vmcnt(0) lgkmcnt(0)" : "+v"(qf[0]), "+v"(qf[1]), "+v"(qf[2]), "+v"(qf[3]) :: "memory");
    ATT_LOADK(jt0); ATT_LOADV(jt0);
    const int vrd = (4 * hh + ((lane & 15) >> 2)) * 128 + (16 * ((lane >> 4) & 1) + 4 * (lane & 3)) * 2;
    const int krd = r32 * 128;
    const int qi = 32 * qb + r32;
#pragma unroll 1
    for (int jt = jt0; jt <= CALEFT; ++jt) {
        asm volatile("s_waitcnt vmcnt(8)" ::: "memory");
        bf16x8 kf[2][4];
#pragma unroll
        for (int kb = 0; kb < 2; ++kb)
#pragma unroll
            for (int s = 0; s < 4; ++s) kf[kb][s] = *(const LAS bf16x8*)(Kb + kb * 4096 + krd + (((2 * s + hh) ^ (r32 & 7)) << 4));
        asm volatile("s_waitcnt lgkmcnt(0)" : "+v"(kf[0][0]), "+v"(kf[0][1]), "+v"(kf[0][2]), "+v"(kf[0][3]), "+v"(kf[1][0]), "+v"(kf[1][1]), "+v"(kf[1][2]), "+v"(kf[1][3]) :: "memory");
        if (jt < CALEFT) { ATT_LOADK(jt + 1); }
        f32x16 s0, s1;
        if (jt <= 3) { const float c_ = bt[ATT_BT - 1];
#pragma unroll
            for (int r_ = 0; r_ < 16; ++r_) { s0[r_] = c_; s1[r_] = c_; } }
        else { const int base_ = qi + 512 - 64 * jt - 4 * hh + 63;
#pragma unroll
            for (int r_ = 0; r_ < 16; ++r_) { const int kk_ = (r_ & 3) + 8 * (r_ >> 2); int i0_ = base_ - kk_, i1_ = base_ - 32 - kk_;
                i0_ = i0_ > ATT_BT - 1 ? ATT_BT - 1 : i0_; i1_ = i1_ > ATT_BT - 1 ? ATT_BT - 1 : i1_; s0[r_] = bt[i0_]; s1[r_] = bt[i1_]; } }
#pragma unroll
        for (int s_ = 0; s_ < 4; ++s_) { s0 = __builtin_amdgcn_mfma_f32_32x32x16_bf16(kf[0][s_], qf[s_], s0, 0, 0, 0); s1 = __builtin_amdgcn_mfma_f32_32x32x16_bf16(kf[1][s_], qf[s_], s1, 0, 0, 0); }
        float mx_ = s0[0];
#pragma unroll
        for (int r_ = 1; r_ < 16; ++r_) mx_ = fmaxf(mx_, s0[r_]);
#pragma unroll
        for (int r_ = 0; r_ < 16; ++r_) mx_ = fmaxf(mx_, s1[r_]);
        mx_ = fmaxf(mx_, __shfl_xor(mx_, 32));
        const float mnew_ = fmaxf(mrun, mx_); const float al_ = __builtin_amdgcn_exp2f((mrun - mnew_) * L2E); const float nm_ = -mnew_ * L2E;
        float ps_ = 0.f;
#pragma unroll
        for (int r_ = 0; r_ < 16; ++r_) { s0[r_] = __builtin_amdgcn_exp2f(s0[r_] * L2E + nm_); s1[r_] = __builtin_amdgcn_exp2f(s1[r_] * L2E + nm_); ps_ += s0[r_] + s1[r_]; }
        lrun = lrun * al_ + ps_;
        if (!__all(mnew_ == mrun)) { if (hh == 0) bc[r32] = al_; LDS_WAIT();
#pragma unroll
            for (int g_ = 0; g_ < 4; ++g_) { const f32x4 av_ = *(const LAS f32x4*)(bc + 8 * g_ + 4 * hh);
#pragma unroll
                for (int c_ = 0; c_ < 4; ++c_) { o0[4 * g_ + c_] *= av_[c_]; o1[4 * g_ + c_] *= av_[c_]; } } }
        mrun = mnew_;
        if (jt < CALEFT) asm volatile("s_waitcnt vmcnt(8)" ::: "memory");
        else asm volatile("s_waitcnt vmcnt(0)" ::: "memory");
        bf16x8 vf[2][2][2];
#pragma unroll
        for (int kb_ = 0; kb_ < 2; ++kb_)
#pragma unroll
            for (int sp_ = 0; sp_ < 2; ++sp_) {
                const LAS unsigned char* vb_ = Vb + (32 * kb_ + 16 * sp_) * 128 + vrd;
                const s16x4 v00_ = vtr16(vb_), v01_ = vtr16(vb_ + 8 * 128), v10_ = vtr16(vb_ + 64), v11_ = vtr16(vb_ + 8 * 128 + 64);
                vf[kb_][sp_][0] = (bf16x8){v00_[0], v00_[1], v00_[2], v00_[3], v01_[0], v01_[1], v01_[2], v01_[3]};
                vf[kb_][sp_][1] = (bf16x8){v10_[0], v10_[1], v10_[2], v10_[3], v11_[0], v11_[1], v11_[2], v11_[3]}; }
        asm volatile("s_waitcnt lgkmcnt(0)" : "+v"(vf[0][0][0]), "+v"(vf[0][0][1]), "+v"(vf[0][1][0]), "+v"(vf[0][1][1]), "+v"(vf[1][0][0]), "+v"(vf[1][0][1]), "+v"(vf[1][1][0]), "+v"(vf[1][1][1]) :: "memory");
        if (jt < CALEFT) { ATT_LOADV(jt + 1); }
#pragma unroll
        for (int kb_ = 0; kb_ < 2; ++kb_)
#pragma unroll
            for (int sp_ = 0; sp_ < 2; ++sp_) {
                const f32x16& sx_ = kb_ ? s1 : s0;
                u32x4 pw_; pw_.x = cvtpk_s(sx_[8 * sp_ + 0], sx_[8 * sp_ + 1]); pw_.y = cvtpk_s(sx_[8 * sp_ + 2], sx_[8 * sp_ + 3]);
                pw_.z = cvtpk_s(sx_[8 * sp_ + 4], sx_[8 * sp_ + 5]); pw_.w = cvtpk_s(sx_[8 * sp_ + 6], sx_[8 * sp_ + 7]);
                const bf16x8 pa_ = __builtin_bit_cast(bf16x8, pw_);
                o0 = __builtin_amdgcn_mfma_f32_32x32x16_bf16(pa_, vf[kb_][sp_][0], o0, 0, 0, 0); o1 = __builtin_amdgcn_mfma_f32_32x32x16_bf16(pa_, vf[kb_][sp_][1], o1, 0, 0, 0); }
    }
#undef ATT_LOADK
#undef ATT_LOADV
#undef ATT_TP
    asm volatile("s_waitcnt vmcnt(0)" ::: "memory");
    { const float lt = lrun + __shfl_xor(lrun, 32); LDS_WAIT(); if (hh == 0) bc[r32] = 1.0f / lt; LDS_WAIT();
#pragma unroll
      for (int g = 0; g < 4; ++g) { const f32x4 av = *(const LAS f32x4*)(bc + 8 * g + 4 * hh);
#pragma unroll
          for (int c = 0; c < 4; ++c) { const int row = 8 * g + 4 * hh + c;
              *(LAS bf16_t*)(Kb + row * 128 + r32 * 2) = (bf16_t)f2bf(o0[4 * g + c] * av[c]); *(LAS bf16_t*)(Kb + row * 128 + 64 + r32 * 2) = (bf16_t)f2bf(o1[4 * g + c] * av[c]); } }
      LDS_WAIT();
      bf16_t* op = MIX + (size_t)(t0 + 32 * qb) * D + 512 + h * 64;
#pragma unroll
      for (int i = 0; i < 4; ++i) { const int p = i * 64 + lane; const u32x4 v = *(const LAS u32x4*)(Kb + p * 16);
          *(u32x4*)(op + (size_t)(p >> 3) * D + 8 * (p & 7)) = v; }
      LDS_WAIT(); }
}
constexpr size_t WS_DN = WS_DNBUF, DN_ITEM = 98304;
static_assert(WS_DN + (size_t)BATCH * DNH * NCH * DN_ITEM <= WS_END, "ws map DN");
__device__ __forceinline__ f32x4 mfma16(bf16x8 a, bf16x8 b, f32x4 c) { return __builtin_amdgcn_mfma_f32_16x16x32_bf16(a, b, c, 0, 0, 0); }
__device__ __forceinline__ int sw256(int row, int ch) { return row * 256 + ((ch ^ (row & 15)) << 4); }
__device__ __forceinline__ int sw128(int row, int ch) { return row * 128 + ((ch ^ (row & 7)) << 4); }
__device__ __forceinline__ int tr256(int row, int col) { return row * 256 + ((((col >> 4) ^ (row & 7))) << 5) + (col & 15) * 2; }
__device__ __forceinline__ bf16x8 trfrag(const LAS unsigned char* img, int k0, int c0, int lane) {
    const int li = lane & 15, q = li >> 2, p = li & 3, kq = lane >> 4, r0 = k0 + 8 * kq + q;
    const s16x4 x = vtr16(img + tr256(r0, c0 + 4 * p)), y = vtr16(img + tr256(r0 + 4, c0 + 4 * p));
    return (bf16x8){x[0], x[1], x[2], x[3], y[0], y[1], y[2], y[3]};
}
__device__ __forceinline__ void conv16(float (&v)[16], const LAS unsigned char* rawT, const LAS float* cwT, int i, int c, int p0) {
#pragma unroll
    for (int k = 0; k < 16; ++k) v[k] = 0.f;
#pragma unroll
    for (int tap = 0; tap < 4; ++tap) { const int lr = i + tap;
        if (p0 + lr >= 0) { const LAS unsigned char* xp = rawT + lr * 256 + c * 32; const u32x4 x0 = *(const LAS u32x4*)xp, x1 = *(const LAS u32x4*)(xp + 16);
            const LAS float* wp = cwT + tap * 384 + c * 16; const f32x4 w0 = *(const LAS f32x4*)wp, w1 = *(const LAS f32x4*)(wp + 4), w2 = *(const LAS f32x4*)(wp + 8), w3 = *(const LAS f32x4*)(wp + 12);
            v[0] += w0.x * bflo(x0.x); v[1] += w0.y * bfhi(x0.x); v[2] += w0.z * bflo(x0.y); v[3] += w0.w * bfhi(x0.y);
            v[4] += w1.x * bflo(x0.z); v[5] += w1.y * bfhi(x0.z); v[6] += w1.z * bflo(x0.w); v[7] += w1.w * bfhi(x0.w);
            v[8] += w2.x * bflo(x1.x); v[9] += w2.y * bfhi(x1.x); v[10] += w2.z * bflo(x1.y); v[11] += w2.w * bfhi(x1.y);
            v[12] += w3.x * bflo(x1.z); v[13] += w3.y * bfhi(x1.z); v[14] += w3.z * bflo(x1.w); v[15] += w3.w * bfhi(x1.w); } }
#pragma unroll
    for (int k = 0; k < 16; k += 2) {
        const f32x2 x = {v[k], v[k + 1]}, ar = x * (f32x2){-1.4426950408889634f, -1.4426950408889634f};
        const f32x2 dn = (f32x2){__builtin_amdgcn_exp2f(ar.x), __builtin_amdgcn_exp2f(ar.y)} + (f32x2){1.0f, 1.0f};
        const f32x2 y = x * (f32x2){__builtin_amdgcn_rcpf(dn.x), __builtin_amdgcn_rcpf(dn.y)};
        v[k] = y.x; v[k + 1] = y.y; }
}
__device__ __forceinline__ u32x4 pack8(const float* v, float s) { u32x4 o; o.x = pk2(v[0] * s, v[1] * s); o.y = pk2(v[2] * s, v[3] * s); o.z = pk2(v[4] * s, v[5] * s); o.w = pk2(v[6] * s, v[7] * s); return o; }

constexpr int DN_RAW_T = 68 * 256, DN_RAW_HI = 90112;
constexpr int DN_CWL_OFF = SMALL_OFF + 8192;
constexpr int DN_BAR_OFF = SMALL_OFF + 5120;
static_assert(DN_CWL_OFF + 6144 + 8 <= LDS_BYTES && DN_RAW_HI + 3 * DN_RAW_T <= RING_BYTES, "dn lds map");
__device__ __forceinline__ void dn_pre_fetch(Frame& F, const Args& a, int item, LAS unsigned char* raw) {
    const int lane = F.lane, w = F.wave, n = item & 63, bh = item >> 6, b = bh >> 2, h = bh & 3;
    const char* P = (const char*)(a.ws + WS_PROJ);
    for (int j = w; j < 51; j += NWAVES) { const int T = j / 17, rg = j - 17 * T; int p = n * CH - 3 + 4 * rg + (lane >> 4); p = p < 0 ? 0 : (p > SEQ - 1 ? SEQ - 1 : p);
        const char* src = P + ((size_t)(b * SEQ + p) * PJ + T * 512 + h * 128) * 2 + (lane & 15) * 16;
        __builtin_amdgcn_global_load_lds((const unsigned*)src, (LAS unsigned*)(raw + T * DN_RAW_T + rg * 1024), 16, 0, 0); }
    if (w >= 6) { const char* src = (const char*)(a.ws + WS_BA) + ((size_t)(b * SEQ + n * CH) * 8) * 4 + (w - 6) * 1024 + lane * 16;
        __builtin_amdgcn_global_load_lds((const unsigned*)src, (LAS unsigned*)(F.lds + DN_BAR_OFF + (w - 6) * 1024), 16, 0, 0); }
}
__device__ __forceinline__ void dn_pre_cw(Frame& F, const Args& a, int h) {
    LAS float* CWL = (LAS float*)(F.lds + DN_CWL_OFF); const float* cw = a.in[3];
    for (int idx = F.tid; idx < 1536; idx += NWAVES * 64) { const int tap = idx / 384, rem = idx - tap * 384, T = rem >> 7, ch = rem & 127; CWL[idx] = cw[tap * 1536 + T * 512 + h * 128 + ch]; }
    if (F.tid == 0) { CWL[1536] = -__expf(a.in[4][h]); CWL[1537] = a.in[5][h]; }
}
__device__ __forceinline__ void dn_pre_item(Frame& F, const Args& a, int item, int nitem, int par) {
    const int tid = F.tid, lane = F.lane, w = F.wave, m = lane & 15, kq = lane >> 4;
    const int n = item & 63, bh = item >> 6, h = bh & 3;
    LAS unsigned char* R = F.lds + RING_OFF;
    const int lo = par ? DN_RAW_HI : 0, hi = par ? 0 : DN_RAW_HI;
    LAS unsigned char* QN = R + 57344; LAS unsigned char* KD = R + 73728;
    LAS unsigned char* KN = R + lo; LAS unsigned char* RV = R + lo + 16384; LAS unsigned char* RK = R + lo + 32768;
    LAS float* Lm = (LAS float*)(R + hi); LAS float* Tm = (LAS float*)(R + hi + 16384);
    LAS unsigned char* WT = R + hi; LAS unsigned char* UT = R + hi + 16384;
    LAS unsigned char* QKM = R + (par ? 32768 : 122880); LAS unsigned char* TB = R + (par ? 40960 : 49152);
    const LAS unsigned char* RAW = R + hi;
    LAS float* beta = (LAS float*)(F.lds + SMALL_OFF); LAS float* gc = beta + 64; LAS float* Wt = beta + 128;
    const LAS float* BAr = (const LAS float*)(F.lds + DN_BAR_OFF); const LAS float* CWL = (const LAS float*)(F.lds + DN_CWL_OFF);
    unsigned char* dst = a.ws + WS_DN + (size_t)item * DN_ITEM;
    VM_WAIT(); __syncthreads();
    if (tid < 64) { const float bl = BAr[tid * 8 + h], al = BAr[tid * 8 + 4 + h] + CWL[1537];
        beta[tid] = sigmoidf_(bl); float g = CWL[1536] * (al > 20.f ? al : log1pf(__expf(al)));
#pragma unroll
        for (int o = 1; o < 64; o <<= 1) { const float t = __shfl_up(g, o); if (lane >= o) g += t; }
        gc[tid] = g; }
    __syncthreads();
    { const int i = tid >> 3, c = tid & 7; const float gi = gc[i], gl = gc[63], bi = beta[i]; const float ei = __expf(gi), di = __expf(gl - gi);
      float v[16];
      conv16(v, RAW, CWL, i, c, n * CH - 3);
      { float ss = 0.f;
#pragma unroll
        for (int k = 0; k < 16; ++k) ss += v[k] * v[k];
        ss += __shfl_xor(ss, 1); ss += __shfl_xor(ss, 2); ss += __shfl_xor(ss, 4);
        const float rq = rsqrtf(ss + EPS) * 0.08838834764831845f;
        *(LAS u32x4*)(QN + sw256(i, 2 * c)) = pack8(v, rq); *(LAS u32x4*)(QN + sw256(i, 2 * c + 1)) = pack8(v + 8, rq); }
      conv16(v, RAW + DN_RAW_T, CWL + 128, i, c, n * CH - 3);
      { float ss = 0.f;
#pragma unroll
        for (int k = 0; k < 16; ++k) ss += v[k] * v[k];
        ss += __shfl_xor(ss, 1); ss += __shfl_xor(ss, 2); ss += __shfl_xor(ss, 4);
        const float rk = rsqrtf(ss + EPS);
        *(LAS u32x4*)(KN + sw256(i, 2 * c)) = pack8(v, rk); *(LAS u32x4*)(KN + sw256(i, 2 * c + 1)) = pack8(v + 8, rk);
        const int tb = i * 256 + ((c ^ (i & 7)) << 5);
        *(LAS u32x4*)(RK + tb) = pack8(v, rk * bi * ei); *(LAS u32x4*)(RK + tb + 16) = pack8(v + 8, rk * bi * ei);
        *(LAS u32x4*)(KD + tb) = pack8(v, rk * di); *(LAS u32x4*)(KD + tb + 16) = pack8(v + 8, rk * di); }
      conv16(v, RAW + 2 * DN_RAW_T, CWL + 256, i, c, n * CH - 3);
      { const int tb = i * 256 + ((c ^ (i & 7)) << 5);
        *(LAS u32x4*)(RV + tb) = pack8(v, bi); *(LAS u32x4*)(RV + tb + 16) = pack8(v + 8, bi); } }
    __syncthreads();
    for (int i = tid; i < 64 * 64; i += NWAVES * 64) Tm[i] = 0.f;
    { const int mat = w >> 2, ib = w & 3; const LAS unsigned char* Aimg = mat ? QN : KN;
      bf16x8 af[4];
#pragma unroll
      for (int s = 0; s < 4; ++s) af[s] = *(const LAS bf16x8*)(Aimg + sw256(16 * ib + m, 4 * s + kq));
#pragma unroll
      for (int jb = 0; jb < 4; ++jb) { f32x4 acc = {0.f, 0.f, 0.f, 0.f};
          if (jb <= ib) {
#pragma unroll
              for (int s = 0; s < 4; ++s) { const bf16x8 bf = *(const LAS bf16x8*)(KN + sw256(16 * jb + m, 4 * s + kq)); acc = mfma16(af[s], bf, acc); } }
          const int j = 16 * jb + m; const float gj = gc[j];
#pragma unroll
          for (int r = 0; r < 4; ++r) { const int i = 16 * ib + 4 * kq + r; const float dec = (i >= j) ? __expf(gc[i] - gj) : 0.f;
              if (mat == 0) Lm[i * 64 + j] = (i > j) ? acc[r] * beta[i] * dec : 0.f;
              else *(LAS bf16_t*)(QKM + sw128(i, j >> 3) + (j & 7) * 2) = (bf16_t)f2bf(acc[r] * dec); } } }
    __syncthreads();
    {
    if (tid < 64) { const int bi = tid >> 4, c = tid & 15; float x[16];
        f32x4 rowv[4] = {{0.f, 0.f, 0.f, 0.f}, {0.f, 0.f, 0.f, 0.f}, {0.f, 0.f, 0.f, 0.f}, {0.f, 0.f, 0.f, 0.f}};
#pragma unroll
        for (int r = 0; r < 16; ++r) { f32x4 nx[4] = {{0.f, 0.f, 0.f, 0.f}, {0.f, 0.f, 0.f, 0.f}, {0.f, 0.f, 0.f, 0.f}, {0.f, 0.f, 0.f, 0.f}};
            if (r + 1 < 16) {
#pragma unroll
                for (int q = 0; q < 4; ++q) if (4 * q < r + 1) nx[q] = *(const LAS f32x4*)(Lm + (16 * bi + r + 1) * 64 + 16 * bi + 4 * q); }
            float s = (r == c) ? 1.f : 0.f;
#pragma unroll
            for (int k = 0; k < r; ++k) s -= rowv[k >> 2][k & 3] * x[k];
            x[r] = s;
#pragma unroll
            for (int q = 0; q < 4; ++q) rowv[q] = nx[q]; }
#pragma unroll
        for (int r = 0; r < 16; ++r) Tm[(16 * bi + r) * 64 + 16 * bi + c] = x[r]; }
    __syncthreads();
    if (w < 2) { const int bi = 2 * w + 1, bj = 2 * w;
        f32x4 wa = {0.f, 0.f, 0.f, 0.f}, t = {0.f, 0.f, 0.f, 0.f};
#pragma unroll
        for (int s_ = 0; s_ < 4; ++s_) wa = __builtin_amdgcn_mfma_f32_16x16x4f32(Lm[(16 * bi + m) * 64 + 16 * bj + 4 * s_ + kq], Tm[(16 * bj + 4 * s_ + kq) * 64 + 16 * bj + m], wa, 0, 0, 0);
#pragma unroll
        for (int s_ = 0; s_ < 4; ++s_) t = __builtin_amdgcn_mfma_f32_16x16x4f32(Tm[(16 * bi + m) * 64 + 16 * bi + 4 * kq + s_], wa[s_], t, 0, 0, 0);
#pragma unroll
        for (int r = 0; r < 4; ++r) Tm[(16 * bi + 4 * kq + r) * 64 + 16 * bj + m] = -t[r]; }
    __syncthreads();
    if (w < 2) { const int J = w;
        f32x4 w0 = {0.f, 0.f, 0.f, 0.f}, w1 = {0.f, 0.f, 0.f, 0.f}, t0 = {0.f, 0.f, 0.f, 0.f}, t1 = {0.f, 0.f, 0.f, 0.f};
#pragma unroll
        for (int ks = 0; ks < 8; ++ks) { const int k = 4 * ks + kq; const float bb = Tm[k * 64 + 16 * J + m];
            w0 = __builtin_amdgcn_mfma_f32_16x16x4f32(Lm[(32 + m) * 64 + k], bb, w0, 0, 0, 0); w1 = __builtin_amdgcn_mfma_f32_16x16x4f32(Lm[(48 + m) * 64 + k], bb, w1, 0, 0, 0); }
#pragma unroll
        for (int s_ = 0; s_ < 4; ++s_) { t0 = __builtin_amdgcn_mfma_f32_16x16x4f32(Tm[(32 + m) * 64 + 32 + 4 * kq + s_], w0[s_], t0, 0, 0, 0);
            t1 = __builtin_amdgcn_mfma_f32_16x16x4f32(Tm[(48 + m) * 64 + 32 + 4 * kq + s_], w0[s_], t1, 0, 0, 0); }
#pragma unroll
        for (int s_ = 0; s_ < 4; ++s_) t1 = __builtin_amdgcn_mfma_f32_16x16x4f32(Tm[(48 + m) * 64 + 48 + 4 * kq + s_], w1[s_], t1, 0, 0, 0);
#pragma unroll
        for (int r = 0; r < 4; ++r) { Tm[(32 + 4 * kq + r) * 64 + 16 * J + m] = -t0[r]; Tm[(48 + 4 * kq + r) * 64 + 16 * J + m] = -t1[r]; } }
    __syncthreads();
    }
    { const int i = tid >> 3, ch = tid & 7; const f32x4 t0v = *(const LAS f32x4*)(Tm + i * 64 + 8 * ch), t1v = *(const LAS f32x4*)(Tm + i * 64 + 8 * ch + 4);
      u32x4 o; o.x = pk2(t0v.x, t0v.y); o.y = pk2(t0v.z, t0v.w); o.z = pk2(t1v.x, t1v.y); o.w = pk2(t1v.z, t1v.w);
      *(LAS u32x4*)(TB + sw128(i, ch)) = o; }
    __syncthreads();
    { const LAS unsigned char* src = (w < 4) ? RV : RK; LAS unsigned char* dstT = (w < 4) ? UT : WT;
      bf16x8 tf[4][2];
#pragma unroll
      for (int ib = 0; ib < 4; ++ib)
#pragma unroll
          for (int s = 0; s < 2; ++s) tf[ib][s] = *(const LAS bf16x8*)(TB + sw128(16 * ib + m, 4 * s + kq));
      __syncthreads();
#pragma unroll
      for (int cbi = 0; cbi < 2; ++cbi) { const int cb = 2 * (w & 3) + cbi;
          const bf16x8 b0 = trfrag(src, 0, 16 * cb, lane), b1 = trfrag(src, 32, 16 * cb, lane);
#pragma unroll
          for (int ib = 0; ib < 4; ++ib) { f32x4 acc = {0.f, 0.f, 0.f, 0.f}; acc = mfma16(tf[ib][0], b0, acc); acc = mfma16(tf[ib][1], b1, acc);
              u32x2 pk; pk.x = pk2(acc[0], acc[1]); pk.y = pk2(acc[2], acc[3]);
              *(LAS u32x2*)(dstT + sw128(16 * cb + m, 2 * ib + (kq >> 1)) + (kq & 1) * 8) = pk; } } }
    __syncthreads();
    if (nitem >= 0) dn_pre_fetch(F, a, nitem, R + lo);
    {
    {
      const bf16x8 kd0 = trfrag(KD, 0, 16 * w, lane), kd1 = trfrag(KD, 32, 16 * w, lane);
      f32x4 acc[8];
#pragma unroll
      for (int nb = 0; nb < 8; ++nb) { acc[nb] = (f32x4){0.f, 0.f, 0.f, 0.f};
          const bf16x8 w0 = *(const LAS bf16x8*)(WT + sw128(16 * nb + m, kq)), w1 = *(const LAS bf16x8*)(WT + sw128(16 * nb + m, 4 + kq));
          acc[nb] = mfma16(w0, kd0, acc[nb]); acc[nb] = mfma16(w1, kd1, acc[nb]); }
      const float cd = __expf(gc[63]); const int arow = 16 * w + m;
#pragma unroll
      for (int sp = 0; sp < 4; ++sp) { float vals[8];
#pragma unroll
          for (int r = 0; r < 4; ++r) { const int b0c = 32 * sp + 4 * kq + r, b1c = b0c + 16;
              vals[r] = ((b0c == arow) ? cd : 0.f) - acc[2 * sp][r]; vals[4 + r] = ((b1c == arow) ? cd : 0.f) - acc[2 * sp + 1][r]; }
          *(u32x4*)(dst + (size_t)arow * 256 + (4 * sp + kq) * 16) = pack8(vals, 1.0f); } }
    {
      const int mi = w & 3, hf = w >> 2, irow = 16 * mi + m; const float ei = __expf(gc[irow]);
      const bf16x8 q0 = *(const LAS bf16x8*)(QKM + sw128(irow, kq)), q1 = *(const LAS bf16x8*)(QKM + sw128(irow, 4 + kq));
      f32x4 acc[4];
#pragma unroll
      for (int nbi = 0; nbi < 4; ++nbi) { const int nb = 4 * hf + nbi; acc[nbi] = (f32x4){0.f, 0.f, 0.f, 0.f};
          const bf16x8 w0 = *(const LAS bf16x8*)(WT + sw128(16 * nb + m, kq)), w1 = *(const LAS bf16x8*)(WT + sw128(16 * nb + m, 4 + kq));
          acc[nbi] = mfma16(w0, q0, acc[nbi]); acc[nbi] = mfma16(w1, q1, acc[nbi]); }
#pragma unroll
      for (int spi = 0; spi < 2; ++spi) { const int sp = 2 * hf + spi; float vals[8];
#pragma unroll
          for (int x = 0; x < 2; ++x) { const int nb = 2 * sp + x, col = 16 * nb + 4 * kq;
              const u32x2 qq = *(const LAS u32x2*)(QN + sw256(irow, col >> 3) + (col & 7) * 2);
              vals[4 * x + 0] = bflo(qq.x) * ei - acc[2 * spi + x][0]; vals[4 * x + 1] = bfhi(qq.x) * ei - acc[2 * spi + x][1];
              vals[4 * x + 2] = bflo(qq.y) * ei - acc[2 * spi + x][2]; vals[4 * x + 3] = bfhi(qq.y) * ei - acc[2 * spi + x][3]; }
          *(u32x4*)(dst + 32768 + (size_t)irow * 256 + (4 * sp + kq) * 16) = pack8(vals, 1.0f); } }
    {
      const bf16x8 u0 = *(const LAS bf16x8*)(UT + sw128(16 * w + m, kq)), u1 = *(const LAS bf16x8*)(UT + sw128(16 * w + m, 4 + kq));
      u32x2 ob[8];
#pragma unroll
      for (int ib = 0; ib < 8; ++ib) { f32x4 acc = {0.f, 0.f, 0.f, 0.f};
          acc = mfma16(trfrag(KD, 0, 16 * ib, lane), u0, acc); acc = mfma16(trfrag(KD, 32, 16 * ib, lane), u1, acc);
          ob[ib].x = pk2(acc[0], acc[1]); ob[ib].y = pk2(acc[2], acc[3]); }
      LAS unsigned char* stg = R + (par ? 40960 : 131072) + w * 2048;
#pragma unroll
      for (int r = 0; r < 2; ++r) {
          if ((lane >> 5) == r) {
#pragma unroll
              for (int q = 0; q < 4; ++q) *(LAS u32x4*)(stg + (lane & 31) * 64 + q * 16) = (u32x4){ob[2 * q].x, ob[2 * q].y, ob[2 * q + 1].x, ob[2 * q + 1].y}; }
          LDS_WAIT();
          const u32x4 s0 = *(const LAS u32x4*)(stg + lane * 16), s1 = *(const LAS u32x4*)(stg + 1024 + lane * 16);
          LDS_WAIT();
          unsigned char* gp = dst + 49152 + (size_t)w * 4096 + r * 2048 + lane * 16;
          *(u32x4*)gp = s0; *(u32x4*)(gp + 1024) = s1; }
      u32x2 oo[4];
#pragma unroll
      for (int ib = 0; ib < 4; ++ib) { f32x4 acc = {0.f, 0.f, 0.f, 0.f};
          acc = mfma16(u0, *(const LAS bf16x8*)(QKM + sw128(16 * ib + m, kq)), acc); acc = mfma16(u1, *(const LAS bf16x8*)(QKM + sw128(16 * ib + m, 4 + kq)), acc);
          oo[ib].x = pk2(acc[0], acc[1]); oo[ib].y = pk2(acc[2], acc[3]); }
      *(LAS u32x4*)(stg + lane * 32) = (u32x4){oo[0].x, oo[0].y, oo[1].x, oo[1].y}; *(LAS u32x4*)(stg + lane * 32 + 16) = (u32x4){oo[2].x, oo[2].y, oo[3].x, oo[3].y};
      LDS_WAIT();
      { const u32x4 s0 = *(const LAS u32x4*)(stg + lane * 16), s1 = *(const LAS u32x4*)(stg + 1024 + lane * 16);
        LDS_WAIT();
        unsigned char* gp = dst + 81920 + (size_t)w * 2048 + lane * 16;
        *(u32x4*)gp = s0; *(u32x4*)(gp + 1024) = s1; } }
    }
}

template <int NSPLIT>
__device__ __forceinline__ void dn_scan(Frame& F, const Args& a, int item) {
    const int bh = item / NSPLIT, part = item % NSPLIT, NACT = 8 / NSPLIT;
    const int tid = F.tid, lane = F.lane, wv = F.wave, m = lane & 15, kq = lane >> 4, b = bh >> 2, h = bh & 3;
    const bool act = wv < NACT; const int w = part * NACT + (act ? wv : 0);
    if (act) __builtin_amdgcn_s_setprio(2);
    LAS unsigned char* R = F.lds + RING_OFF;
    LAS unsigned char* CI = R + 98304 + wv * 6144;
    bf16_t* MIX = (bf16_t*)(a.ws + WS_XN);
    const unsigned char* base = a.ws + WS_DN + (size_t)(bh * 64) * DN_ITEM;
    f32x4 S[8];
#pragma unroll
    for (int ib = 0; ib < 8; ++ib) S[ib] = (f32x4){0.f, 0.f, 0.f, 0.f};
#define DN_STAGE(n_, buf_) do { const unsigned char* ib_ = base + (size_t)(n_) * DN_ITEM; \
        _Pragma("unroll") for (int p_ = 0; p_ < 6; ++p_) { const int off_ = p_ * 8192 + tid * 16, row_ = off_ >> 8, pc_ = (off_ >> 4) & 15; \
            __builtin_amdgcn_global_load_lds((const unsigned*)(ib_ + row_ * 256 + ((pc_ ^ (row_ & 15)) << 4)), (LAS unsigned*)(R + (buf_) * 49152 + p_ * 8192 + wv * 1024), 16, 0, 0); } } while (0)
#define DN_STAGEC(n_) do { const unsigned char* ib_ = base + (size_t)(n_) * DN_ITEM; \
        _Pragma("unroll") for (int q_ = 0; q_ < 4; ++q_) __builtin_amdgcn_global_load_lds((const unsigned*)(ib_ + 49152 + (size_t)(w * 64 + lane) * 64 + q_ * 16), (LAS unsigned*)(CI + q_ * 1024), 16, 0, 0); \
        _Pragma("unroll") for (int q_ = 0; q_ < 2; ++q_) __builtin_amdgcn_global_load_lds((const unsigned*)(ib_ + 81920 + (size_t)(w * 64 + lane) * 32 + q_ * 16), (LAS unsigned*)(CI + 4096 + q_ * 1024), 16, 0, 0); } while (0)
    DN_STAGE(0, 0); if (act) { DN_STAGEC(0); }
    bf16_t* mp = MIX + (size_t)(b * SEQ + m) * D + h * 128 + 16 * w + 4 * kq;
#pragma unroll 1
    for (int n = 0; n < NCH; ++n) {
        asm volatile("s_waitcnt vmcnt(0)" ::: "memory");
        __syncthreads();
        if (!act) { if (n + 1 < NCH) { DN_STAGE(n + 1, (n + 1) & 1); } continue; }
        if (n + 1 < NCH) { DN_STAGE(n + 1, (n + 1) & 1); }
        u32x4 bn[4], oi[2];
#pragma unroll
        for (int q = 0; q < 4; ++q) bn[q] = *(const LAS u32x4*)(CI + q * 1024 + lane * 16);
        oi[0] = *(const LAS u32x4*)(CI + 4096 + lane * 16); oi[1] = *(const LAS u32x4*)(CI + 5120 + lane * 16);
        asm volatile("s_waitcnt lgkmcnt(0)" : "+v"(bn[0]), "+v"(bn[1]), "+v"(bn[2]), "+v"(bn[3]), "+v"(oi[0]), "+v"(oi[1]) :: "memory");
        if (n + 1 < NCH) { DN_STAGEC(n + 1); }
        const LAS unsigned char* buf = R + (n & 1) * 49152;
        bf16x8 sf[4];
#pragma unroll
        for (int s = 0; s < 4; ++s) { u32x4 pw; pw.x = cvtpk_s(S[2 * s][0], S[2 * s][1]); pw.y = cvtpk_s(S[2 * s][2], S[2 * s][3]);
            pw.z = cvtpk_s(S[2 * s + 1][0], S[2 * s + 1][1]); pw.w = cvtpk_s(S[2 * s + 1][2], S[2 * s + 1][3]); sf[s] = __builtin_bit_cast(bf16x8, pw); }
        const unsigned bnw[16] = {bn[0].x, bn[0].y, bn[0].z, bn[0].w, bn[1].x, bn[1].y, bn[1].z, bn[1].w, bn[2].x, bn[2].y, bn[2].z, bn[2].w, bn[3].x, bn[3].y, bn[3].z, bn[3].w};
        const unsigned oiw[8] = {oi[0].x, oi[0].y, oi[0].z, oi[0].w, oi[1].x, oi[1].y, oi[1].z, oi[1].w};
#define DN_LDBLK(FR, row0_) do { _Pragma("unroll") for (int j_ = 0; j_ < 2; ++j_) _Pragma("unroll") for (int s_ = 0; s_ < 4; ++s_) FR[j_][s_] = *(const LAS bf16x8*)(buf + sw256((row0_) + 16 * j_ + m, 4 * s_ + kq)); } while (0)
#define DN_MMAS(FR, ib0_) do { _Pragma("unroll") for (int j_ = 0; j_ < 2; ++j_) { const int ib_ = (ib0_) + j_; f32x4 acc_ = {bflo(bnw[2 * ib_]), bfhi(bnw[2 * ib_]), bflo(bnw[2 * ib_ + 1]), bfhi(bnw[2 * ib_ + 1])}; \
            _Pragma("unroll") for (int s_ = 0; s_ < 4; ++s_) acc_ = mfma16(FR[j_][s_], sf[s_], acc_); S[ib_] = acc_; } } while (0)
      \
#define DN_MMAO(FR, ib0_) do { u32x2 pk2_[2]; _Pragma("unroll") for (int j_ = 0; j_ < 2; ++j_) { const int ib_ = (ib0_) + j_; f32x4 acc_ = {bflo(oiw[2 * ib_]), bfhi(oiw[2 * ib_]), bflo(oiw[2 * ib_ + 1]), bfhi(oiw[2 * ib_ + 1])}; \
            _Pragma("unroll") for (int s_ = 0; s_ < 4; ++s_) acc_ = mfma16(sf[s_], FR[j_][s_], acc_); \
            pk2_[j_].x = cvtpk_s(acc_[0], acc_[1]); pk2_[j_].y = cvtpk_s(acc_[2], acc_[3]); } \
        const bool od_ = kq & 1; const u32x2 snd_ = od_ ? pk2_[0] : pk2_[1]; u32x2 rcv_; rcv_.x = (unsigned)__shfl_xor((int)snd_.x, 16); rcv_.y = (unsigned)__shfl_xor((int)snd_.y, 16); \
        const u32x4 w_ = od_ ? (u32x4){rcv_.x, rcv_.y, pk2_[1].x, pk2_[1].y} : (u32x4){pk2_[0].x, pk2_[0].y, rcv_.x, rcv_.y}; \
        *(u32x4*)(mp + (size_t)(n * CH + 16 * ((ib0_) + (od_ ? 1 : 0))) * D - (od_ ? 4 : 0)) = w_; } while (0)
#define DN_SB __builtin_amdgcn_sched_barrier(0)
        bf16x8 fA[2][4], fB[2][4];
        DN_LDBLK(fA, 128);
        DN_SB; DN_LDBLK(fB, 160); DN_MMAO(fA, 0);
        DN_SB; DN_LDBLK(fA, 0);   DN_MMAO(fB, 2);
        DN_SB; DN_LDBLK(fB, 32);  DN_MMAS(fA, 0);
        DN_SB; DN_LDBLK(fA, 64);  DN_MMAS(fB, 2);
        DN_SB; DN_LDBLK(fB, 96);  DN_MMAS(fA, 4);
        DN_SB; DN_MMAS(fB, 6);
        DN_SB;
#undef DN_LDBLK
#undef DN_MMAS
#undef DN_MMAO
#undef DN_SB
    }
    __builtin_amdgcn_s_setprio(0);
    __syncthreads();
#undef DN_STAGE
#undef DN_STAGEC
}
__device__ __forceinline__ void mixnorm_phase(Frame& F, const Args& a, bf16_t* MIXO) {
    const bf16_t* PROJ = (const bf16_t*)(a.ws + WS_PROJ);
    const float* dn_w = a.in[6]; const float* at_w = a.in[8]; bf16_t* MIX = (bf16_t*)(a.ws + WS_XN);
    const int lane = F.lane, gw = F.vcu * NWAVES + F.wave, NGW = F.G * NWAVES;
    const int d0 = (8 * lane) & 127;
    const f32x4 dw0 = *(const f32x4*)(dn_w + d0), dw1 = *(const f32x4*)(dn_w + d0 + 4), aw0 = *(const f32x4*)(at_w + 8 * lane), aw1 = *(const f32x4*)(at_w + 8 * lane + 4);
    u32x4 noa = {}, nzz = {}, nob = {};
    if (gw < M) { noa = *(const u32x4*)(MIX + (size_t)gw * D + 8 * lane); nzz = *(const u32x4*)(PROJ + (size_t)gw * PJ + ZA + 8 * lane); nob = *(const u32x4*)(MIX + (size_t)gw * D + 512 + 8 * lane); }
    for (int t = gw; t < M; t += NGW) {
    const u32x4 oa = noa, zz = nzz, ob = nob;
    if (t + NGW < M) { const int tn = t + NGW; noa = *(const u32x4*)(MIX + (size_t)tn * D + 8 * lane); nzz = *(const u32x4*)(PROJ + (size_t)tn * PJ + ZA + 8 * lane); nob = *(const u32x4*)(MIX + (size_t)tn * D + 512 + 8 * lane); }
    {
      const f32x4 a0 = {bflo(oa.x), bfhi(oa.x), bflo(oa.y), bfhi(oa.y)}, a1 = {bflo(oa.z), bfhi(oa.z), bflo(oa.w), bfhi(oa.w)};
      float s = (a0.x * a0.x + a0.y * a0.y) + (a0.z * a0.z + a0.w * a0.w) + (a1.x * a1.x + a1.y * a1.y) + (a1.z * a1.z + a1.w * a1.w);
#pragma unroll
      for (int o = 1; o < 16; o <<= 1) s += __shfl_xor(s, o);
      const float rs = rsqrtf(s * (1.f / 128.f) + EPS);
      const f32x4 w0 = dw0, w1 = dw1;
      float r[8] = {a0.x * rs * w0.x, a0.y * rs * w0.y, a0.z * rs * w0.z, a0.w * rs * w0.w, a1.x * rs * w1.x, a1.y * rs * w1.y, a1.z * rs * w1.z, a1.w * rs * w1.w};
      const float z[8] = {bflo(zz.x), bfhi(zz.x), bflo(zz.y), bfhi(zz.y), bflo(zz.z), bfhi(zz.z), bflo(zz.w), bfhi(zz.w)};
#pragma unroll
      for (int i = 0; i < 8; ++i) r[i] *= siluf_(z[i]);
      u32x4 o; o.x = pk2(r[0], r[1]); o.y = pk2(r[2], r[3]); o.z = pk2(r[4], r[5]); o.w = pk2(r[6], r[7]);
      *(u32x4*)(MIXO + (size_t)t * D + 8 * lane) = o; }
    {
      const float v[8] = {bflo(ob.x), bfhi(ob.x), bflo(ob.y), bfhi(ob.y), bflo(ob.z), bfhi(ob.z), bflo(ob.w), bfhi(ob.w)};
      float s = 0.f;
#pragma unroll
      for (int i = 0; i < 8; ++i) s += v[i] * v[i];
      s = wave_sum(s);
      const float rs = rsqrtf(s * (1.f / 512.f) + EPS);
      const f32x4 w0 = aw0, w1 = aw1;
      u32x4 o; o.x = pk2(v[0] * rs * w0.x, v[1] * rs * w0.y); o.y = pk2(v[2] * rs * w0.z, v[3] * rs * w0.w); o.z = pk2(v[4] * rs * w1.x, v[5] * rs * w1.y); o.w = pk2(v[6] * rs * w1.z, v[7] * rs * w1.w);
      *(u32x4*)(MIXO + (size_t)t * D + 512 + 8 * lane) = o; }
    }
}
enum { PH_PRO = 0, PH_INPROJ = 1, PH_DNPRE = 2, PH_MIX = 3, PH_MIXNORM = 4, PH_OUTPROJ = 5, PH_ROUTER = 6, PH_GU = 7, PH_DOWN = 8, PH_FINAL = 9, PH_END = 10 };

__global__ void __launch_bounds__(NWAVES * 64, 2) fwd_kernel(Args args) {
    extern __shared__ __attribute__((aligned(16))) unsigned char lds[];
    Frame F;
    F.lds = (LAS unsigned char*)lds;
    F.MISC = (volatile LAS unsigned*)(F.lds + MISC_OFF);
    F.tid = threadIdx.x; F.lane = F.tid & 63; F.wave = __builtin_amdgcn_readfirstlane(F.tid >> 6);
    F.G = gridDim.x; { const int bx = blockIdx.x; F.vcu = (F.G % 8 == 0) ? (bx % 8) * (F.G / 8) + bx / 8 : bx; }
    unsigned char* ws = args.ws;
    F.ctl = (gu32*)(ws + WS_CTL);
    for (int u = F.tid; u < (LDS_BYTES - LDSCTL_OFF) / 4; u += NWAVES * 64) ((LAS unsigned*)(F.lds + LDSCTL_OFF))[u] = 0u;
    __syncthreads();
    const int lo = args.ph_lo, hi = args.ph_hi;
    XcdBarrier bar; bar.bar = (unsigned*)(F.ctl + CW_BAR); bar.x = 0; bar.st = nullptr;
    if (hi - lo > 1) bar = xcd_barrier_post((unsigned*)(F.ctl + CW_BAR), F.MISC + 8);
#define IN(k) (lo <= (k) && (k) < hi)
#define SEAM(k) do { if (IN(k) && IN((k) + 1)) xcd_barrier(bar); } while (0)

    if (IN(PH_PRO)) p0_prologue(F, args);
    SEAM(PH_PRO);
    if (IN(PH_INPROJ)) {
        pg8::DenseOrder S{(const char*)(ws + WS_XN), (const char*)(ws + WS_WINT), M / 256, PJ / 256, D, F.G, (int)blockIdx.x};
        pg8::EpiProj E{(bf16_t*)(ws + WS_PROJ), PJ};
        pg8::gemm_phase<pg8::EpiProj, pg8::DenseOrder, false, true>(F.lds + RING_OFF, D, S, E, nullptr, nullptr); }
    SEAM(PH_INPROJ);
    if (IN(PH_DNPRE)) { constexpr int NIT = BATCH * DNH * NCH;
        if (F.vcu < NIT) dn_pre_fetch(F, args, F.vcu, F.lds + RING_OFF + DN_RAW_HI);
        int par = 0, hl = -1;
        for (int it = F.vcu; it < NIT; it += F.G, par ^= 1) { const int hh = (it >> 6) & 3;
            if (hh != hl) { __syncthreads(); dn_pre_cw(F, args, hh); hl = hh; }
            dn_pre_item(F, args, it, (it + F.G < NIT) ? it + F.G : -1, par); }
        __syncthreads(); }
    SEAM(PH_DNPRE);
    if (IN(PH_MIX)) {
        constexpr int NSP = 2; const int nd = F.G / 2 < 32 * NSP ? F.G / 2 : 32 * NSP;
        if ((int)blockIdx.x < nd) { for (int it = blockIdx.x; it < BATCH * DNH * NSP; it += nd) {
                const int sit = (nd == 64) ? ((((it >> 4) * 8 + (it & 7)) << 1) | ((it >> 3) & 1)) : it;
                dn_scan<NSP>(F, args, sit); } }
        else if (F.G == 256 && nd == 64) {
            const int a_ = (int)blockIdx.x - 64, x_ = a_ & 7, l_ = a_ >> 3; int hl = -1;
            for (int q = l_; q < 128; q += 24) attn_item(F, args, (2 * (x_ >> 1) + (q >> 6)) * 128 + (q & 63) * 2 + (x_ & 1), (bf16_t*)(ws + WS_XN), hl);
            p5_convert_wd_wave(F, args, a_ * NWAVES + F.wave, 192 * NWAVES);
            p5_convert_gu_wave(F, args, a_ * NWAVES + F.wave, 192 * NWAVES, MIX_GU_EXPERTS); }
        else { int hl = -1; for (int it = blockIdx.x - nd; it < BATCH * NCH * 2; it += F.G - nd) attn_item(F, args, it, (bf16_t*)(ws + WS_XN), hl); } }
    SEAM(PH_MIX);
    if (IN(PH_MIXNORM)) mixnorm_phase(F, args, (bf16_t*)(ws + WS_XN));
    SEAM(PH_MIXNORM);
    if (IN(PH_OUTPROJ)) {
        pg8::DenseOrder S{(const char*)(ws + WS_XN), (const char*)(ws + WS_WOT), M / 256, D / 256, D, F.G, (int)blockIdx.x};
        pg8::EpiProj E{(bf16_t*)args.out, D};
        pg8::gemm_phase<pg8::EpiProj, pg8::DenseOrder, false, true>(F.lds + RING_OFF, D, S, E, nullptr, nullptr); }
    SEAM(PH_OUTPROJ);
    if (IN(PH_ROUTER)) {
#pragma unroll 1
        for (int st = 0; st < 2; ++st) { if (((st ^ F.vcu) & 1) == 0) p5_router_mfma(F, args); else p5_convert_experts(F, args, (F.G == 256) ? 2 : 3, (F.G == 256) ? MIX_GU_EXPERTS : 0); __syncthreads(); } }
    SEAM(PH_ROUTER);
    if (IN(PH_GU)) {
        const int nT = moe_tables(F, args);
        MoeOrder S{(const LAS int*)(F.lds + SMALL_OFF), nullptr, (const char*)wgu8_base(args), nT, (2 * FF) / 256, F.G, (int)blockIdx.x, (size_t)2 * FF * D, 0, (size_t)256 * D, 0};
        pg8::EpiSwiglu E{(bf16_t*)(ws + WS_ACT), args.in[14], args.in[16], (const float*)(ws + WS_LRS), 1.0f / 32.0f};
        pg8::gemm_phase<pg8::EpiSwiglu, MoeOrder, true, true, true>(F.lds + RING_OFF, D / 2, S, E, (const char*)(ws + WS_H8), (const int*)(ws + WS_LMETA)); }
    SEAM(PH_GU);
    if (IN(PH_DOWN)) {
        const int nT = moe_tables(F, args);
        MoeOrder S{(const LAS int*)(F.lds + SMALL_OFF), (const char*)(ws + WS_ACT), (const char*)(ws + WS_WD), nT, D / 256, F.G, (int)blockIdx.x, (size_t)D * FF, 1, (size_t)256 * FF, (size_t)FF};
        pg8::EpiDown E{(bf16_t*)args.out, (bf16_t*)(ws + WS_Y23), args.in[18], (const int*)(ws + WS_LMETA), (const float*)(ws + WS_LGATE)};
        pg8::gemm_phase<pg8::EpiDown, MoeOrder, false, true, true>(F.lds + RING_OFF, FF / 2, S, E, nullptr, nullptr); }
    SEAM(PH_DOWN);
    if (IN(PH_FINAL)) p9_final(F, args);
#undef IN
#undef SEAM
}

extern "C" void kernel_launch(void* const* d_in, const int* in_sizes, int n_in, void* d_out, int out_size, void* d_ws, size_t ws_size, hipStream_t stream) {
    static int grid = 0;
    if (grid == 0) {
        if (n_in != 20 || in_sizes[0] != M * D || out_size != M * D || ws_size < WS_END) { fprintf(stderr, "kernel_launch: unexpected shapes (n_in %d, in0 %d, out %d, ws %zu < %zu)\n", n_in, n_in > 0 ? in_sizes[0] : -1, out_size, ws_size, (size_t)WS_END); grid = -1; return; }
        int dev = 0, cus = 0;
        if (hipGetDevice(&dev) != hipSuccess || hipDeviceGetAttribute(&cus, hipDeviceAttributeMultiprocessorCount, dev) != hipSuccess) { grid = -1; return; }
        if (hipFuncSetAttribute((const void*)fwd_kernel, hipFuncAttributeMaxDynamicSharedMemorySize, LDS_BYTES) != hipSuccess) { grid = -1; return; }
        (void)hipGetLastError();
        grid = cus;
        if (grid != 256) fprintf(stderr, "kernel_launch: %d CUs; this kernel is built for 256\n", grid);
    }
    if (grid < 0) return;
    unsigned char* ws = (unsigned char*)d_ws;
    (void)hipMemsetAsync(ws + WS_CTL, 0, CTL_ZERO_BYTES, stream);
    Args a{};
    for (int i = 0; i < 20; ++i) a.in[i] = (const float*)d_in[i];
    a.out = (float*)d_out; a.ws = ws;
#define LAUNCH(lo_, hi_) do { a.ph_lo = (lo_); a.ph_hi = (hi_); hipLaunchKernelGGL(fwd_kernel, dim3(grid), dim3(NWAVES * 64), LDS_BYTES, stream, a); } while (0)
    LAUNCH(PH_PRO, PH_END);
#undef LAUNCH
}
```
